# Optimizing an MI355X kernel written in HIP

```python
import math
import jax, jax.numpy as jnp
from jax import lax
import numpy as np

D_MODEL = 1024
BATCH = 4
SEQ = 8192
DEPTH = 2

CHUNK = 64
Q_BLOCK = 128
HEAD_DIM = 64
H_FOX = 8
H_CHK = 8
W_FOX = H_FOX * HEAD_DIM
W_CHK = H_CHK * HEAD_DIM
LEFT_CHUNKS = 8
MAX_REL = 128
N_REL = 2 * MAX_REL + 1
N_BRANCH = 2
D_FF = 4 * D_MODEL
EPS = 1e-6
NEG = -1e30
N_IN = 3 * W_FOX + H_FOX + 3 * W_CHK + N_BRANCH * D_MODEL
SPLITS = tuple(np.cumsum([W_FOX, W_FOX, W_FOX, H_FOX, W_CHK, W_CHK, W_CHK]).tolist())

kernel_name = "hybrid_fox_chunkattn_gated_block"


def rms_norm(x, g):
    xf = x.astype(jnp.float32)
    y = xf * lax.rsqrt(jnp.mean(xf * xf, axis=-1, keepdims=True) + EPS)
    return (y * g.astype(jnp.float32)).astype(x.dtype)


def to_heads(t, h):
    b, s, _ = t.shape
    return t.reshape(b, s, h, HEAD_DIM).transpose(0, 2, 1, 3)


def from_heads(t):
    b, h, s, d = t.shape
    return t.transpose(0, 2, 1, 3).reshape(b, s, h * d)


def forgetting_attention(q, k, v, log_f):
    b, h, s, d = q.shape
    nblk = s // Q_BLOCK
    scale = 1.0 / math.sqrt(d)
    c = jnp.cumsum(log_f, axis=-1)
    qb = q.reshape(b, h, nblk, Q_BLOCK, d).transpose(2, 0, 1, 3, 4)
    cb = c.reshape(b, h, nblk, Q_BLOCK).transpose(2, 0, 1, 3)
    key_pos = jnp.arange(s, dtype=jnp.int32)

    def block(args):
        qi, ci, i = args
        sc = jnp.einsum('bhqd,bhkd->bhqk', qi, k, preferred_element_type=jnp.float32)
        sc = sc * scale + ci[..., None] - c[:, :, None, :]
        tq = i * Q_BLOCK + jnp.arange(Q_BLOCK, dtype=jnp.int32)
        mask = key_pos[None, :] <= tq[:, None]
        sc = jnp.where(mask, sc, NEG)
        p = jax.nn.softmax(sc, axis=-1).astype(v.dtype)
        return jnp.einsum('bhqk,bhkd->bhqd', p, v)

    out = lax.map(block, (qb, cb, jnp.arange(nblk, dtype=jnp.int32)))
    return out.transpose(1, 2, 0, 3, 4).reshape(b, h, s, d)


def chunk_band_attention(q, k, v, rel_bias):
    b, h, s, d = q.shape
    nblk = s // Q_BLOCK
    scale = 1.0 / math.sqrt(d)
    pad = LEFT_CHUNKS * CHUNK
    band = pad + Q_BLOCK
    kp = jnp.pad(k, ((0, 0), (0, 0), (pad, 0), (0, 0)))
    vp = jnp.pad(v, ((0, 0), (0, 0), (pad, 0), (0, 0)))
    qb = q.reshape(b, h, nblk, Q_BLOCK, d).transpose(2, 0, 1, 3, 4)

    def block(args):
        qi, i = args
        p0 = i * Q_BLOCK
        kb = lax.dynamic_slice_in_dim(kp, p0, band, axis=2)
        vb = lax.dynamic_slice_in_dim(vp, p0, band, axis=2)
        tq = p0 + jnp.arange(Q_BLOCK, dtype=jnp.int32)
        sk = p0 - pad + jnp.arange(band, dtype=jnp.int32)
        cq = tq // CHUNK
        ck = sk // CHUNK
        valid = (sk[None, :] >= 0) & (ck[None, :] <= cq[:, None]) & (ck[None, :] >= cq[:, None] - LEFT_CHUNKS)
        rel = jnp.clip(tq[:, None] - sk[None, :], -MAX_REL, MAX_REL) + MAX_REL
        bias = rel_bias[:, rel].astype(jnp.float32)
        sc = jnp.einsum('bhqd,bhkd->bhqk', qi, kb, preferred_element_type=jnp.float32)
        sc = jnp.where(valid, sc * scale + bias[None], NEG)
        p = jax.nn.softmax(sc, axis=-1).astype(vb.dtype)
        return jnp.einsum('bhqk,bhkd->bhqd', p, vb)

    out = lax.map(block, (qb, jnp.arange(nblk, dtype=jnp.int32)))
    return out.transpose(1, 2, 0, 3, 4).reshape(b, h, s, d)


def setup_inputs(seed: int = 0) -> dict:
    key = jax.random.key(seed)
    ks = jax.random.split(key, 14)
    nrm = lambda k, shape, fan_in: jax.random.normal(k, shape, jnp.float32) * (fan_in ** -0.5)
    x = jax.random.normal(ks[0], (BATCH, SEQ, D_MODEL), jnp.float32)
    norm1 = 1.0 + 0.02 * jax.random.normal(ks[1], (DEPTH, D_MODEL), jnp.float32)
    w_in = nrm(ks[2], (DEPTH, D_MODEL, N_IN), D_MODEL)
    forget_bias = jnp.linspace(1.0, 6.0, H_FOX, dtype=jnp.float32)[None, :] + 0.1 * jax.random.normal(ks[3], (DEPTH, H_FOX), jnp.float32)
    rel_bias = 0.5 * jax.random.normal(ks[4], (DEPTH, H_CHK, N_REL), jnp.float32)
    w_branch_a = nrm(ks[5], (DEPTH, W_FOX, D_MODEL), W_FOX)
    w_branch_b = nrm(ks[6], (DEPTH, W_CHK, D_MODEL), W_CHK)
    w_out = nrm(ks[7], (DEPTH, D_MODEL, D_MODEL), D_MODEL)
    norm2 = 1.0 + 0.02 * jax.random.normal(ks[8], (DEPTH, D_MODEL), jnp.float32)
    w_up = nrm(ks[9], (DEPTH, D_MODEL, D_FF), D_MODEL)
    w_down = nrm(ks[10], (DEPTH, D_FF, D_MODEL), D_FF)
    final_norm = 1.0 + 0.02 * jax.random.normal(ks[11], (D_MODEL,), jnp.float32)
    return {"x": x, "norm1": norm1, "w_in": w_in, "forget_bias": forget_bias,
            "rel_bias": rel_bias, "w_branch_a": w_branch_a, "w_branch_b": w_branch_b,
            "w_out": w_out, "norm2": norm2, "w_up": w_up, "w_down": w_down,
            "final_norm": final_norm}


def reference(x, norm1, w_in, forget_bias, rel_bias, w_branch_a, w_branch_b,
              w_out, norm2, w_up, w_down, final_norm):
    for l in range(DEPTH):
        h = rms_norm(x, norm1[l])
        proj = h @ w_in[l]
        qa, ka, va, fa, qc, kc, vc, gates = jnp.split(proj, SPLITS, axis=-1)
        log_f = jax.nn.log_sigmoid((fa + forget_bias[l]).astype(jnp.float32))
        log_f = log_f.transpose(0, 2, 1)
        o_a = from_heads(forgetting_attention(to_heads(qa, H_FOX), to_heads(ka, H_FOX),
                                              to_heads(va, H_FOX), log_f))
        o_b = from_heads(chunk_band_attention(to_heads(qc, H_CHK), to_heads(kc, H_CHK),
                                              to_heads(vc, H_CHK), rel_bias[l]))
        g_a, g_b = jnp.split(jax.nn.sigmoid(gates), N_BRANCH, axis=-1)
        merged = g_a * (o_a @ w_branch_a[l]) + g_b * (o_b @ w_branch_b[l])
        x = x + merged @ w_out[l]
        h2 = rms_norm(x, norm2[l])
        x = x + jnp.square(jax.nn.relu(h2 @ w_up[l])) @ w_down[l]
    return rms_norm(x, final_norm)
```

```cpp
#include <hip/hip_runtime.h>
#include <hip/hip_cooperative_groups.h>
#include <cstdio>
#include <cstdint>
namespace cg = cooperative_groups;
namespace pg8 {
#define PG8_LAS __attribute__((address_space(3)))
typedef unsigned short bf16_t;
typedef short bf16x8 __attribute__((ext_vector_type(8)));
typedef float f32x4 __attribute__((ext_vector_type(4)));
typedef unsigned u32x4 __attribute__((ext_vector_type(4)));
constexpr int BM = 256, BK = 64, HALF = 128, HTB = HALF * BK * 2  , STAGE_BYTES = 8 * HTB, NXCD = 8, WGM = 8;

__host__ __device__ __forceinline__ int lds_byte(int r, int c) { const int st = (r >> 4) * 2 + (c >> 5), rr = r & 15, cc = c & 31, ob = rr * 64 + cc * 2; return st * 1024 + (ob ^ (((ob >> 9) & 1) << 5)); }
__host__ __device__ __forceinline__ void stage_rc(int b, int& R, int& C) { const int st = b / 1024, sb = b % 1024, swz = sb ^ (((sb >> 9) & 1) << 5); R = (st >> 1) * 16 + swz / 64; C = (st & 1) * 32 + (swz % 64) / 2; }
__host__ __device__ __forceinline__ int perm32(int rho) { const int n = rho >> 4, i = rho & 15; return 8 * (i >> 2) + 4 * n + (i & 3); }

struct Unit { int pm, pn, half; };
struct Gemm { const bf16_t* A; const bf16_t* Bt; int M, N, K; const bf16_t* A2; const bf16_t* Bt2; };

struct StaticOrder {
    int nM, nN, nwg, G, c;
    __host__ __device__ void init(int M, int N, int G_, int c_) { nM = M / BM; nN = N / BM; nwg = nM * nN; G = G_; c = c_; }
    __host__ __device__ bool next(int i, Unit& u) const {
        const long L = (long)i * G + c; if (L >= nwg) return false;
        int wgid = (int)L; { const int q = nwg / NXCD, r = nwg % NXCD, xcd = wgid % NXCD, off = wgid / NXCD; wgid = (xcd < r ? xcd * (q + 1) : r * (q + 1) + (xcd - r) * q) + off; }
        const int nig = WGM * nN, gid = wgid / nig, fm = gid * WGM, gsz = (nM - fm) < WGM ? (nM - fm) : WGM;
        u.pm = fm + ((wgid % nig) % gsz); u.pn = (wgid % nig) / gsz; return true;
    }
    __device__ __forceinline__ void a_ready(const Unit&) const {}
    __device__ __forceinline__ void done(const Unit&) const {}
};

__device__ __forceinline__ unsigned cvt_pk_bf16(float lo, float hi) { unsigned r; asm volatile("v_cvt_pk_bf16_f32 %0, %1, %2" : "=v"(r) : "v"(lo), "v"(hi)); return r; }
typedef float f32x2 __attribute__((ext_vector_type(2)));
template <class Epi, class Sched, bool ALIGN_EPI = false, bool SP2 = false>
__device__ __forceinline__ void gemm_phase(PG8_LAS unsigned char* lds, const Gemm g, const Sched& S, const Epi& E) {
    int tid_l = threadIdx.x; asm volatile("" : "+v"(tid_l));
    const int tid = tid_l, wid = __builtin_amdgcn_readfirstlane(tid >> 6), lane = tid & 63, wr = wid >> 2, wc = wid & 3, fr = lane & 15, fq = lane >> 4;
    const int K = g.K, nt = K / BK;
    unsigned voffA[2], voffB[2];
#pragma unroll
    for (int i = 0; i < 2; ++i) { int R, C; stage_rc(tid * 16 + i * 8192, R, C); const int Rb = Epi::PERM ? ((R & ~31) + perm32(R & 31)) : R;
        voffA[i] = (unsigned)(R * K + C) * 2u; voffB[i] = (unsigned)(Rb * K + C) * 2u; }
    const size_t kstep = (size_t)(BK * 2);
    const size_t hstep = (size_t)HALF * K * 2;
    const size_t tstep = 2 * hstep;
    const unsigned ldsw = (unsigned)wid * 1024u;
    const int aoff = lds_byte(wr * 64 + fr, fq * 8), boff = lds_byte(wc * 32 + fr, fq * 8);
#define PG8_SA(b, h) (((b) * 2 + (h)) * HTB)
#define PG8_SB(b, h) ((4 + (b) * 2 + (h)) * HTB)
#define PG8_STAGE(bufoff, gbase, voff) do { _Pragma("unroll") for (int _i = 0; _i < 2; ++_i) \
        __builtin_amdgcn_global_load_lds((const unsigned*)((const char*)(gbase) + (voff)[_i]), (PG8_LAS unsigned*)(lds + (bufoff) + ldsw + _i * 8192), 16, 0, 0); } while (0)
#define PG8_LDA(dst, b, h) do { _Pragma("unroll") for (int m = 0; m < 4; ++m) _Pragma("unroll") for (int k = 0; k < 2; ++k) dst[m][k] = *(const PG8_LAS bf16x8*)(lds + PG8_SA(b, h) + aoff + m * 2048 + k * 1024); } while (0)
#define PG8_LDB(dst, b, h) do { _Pragma("unroll") for (int n = 0; n < 2; ++n) _Pragma("unroll") for (int k = 0; k < 2; ++k) dst[n][k] = *(const PG8_LAS bf16x8*)(lds + PG8_SB(b, h) + boff + n * 2048 + k * 1024); } while (0)
#define PG8_MMA(ai, bj, At, Bt) do { __builtin_amdgcn_s_setprio(1); _Pragma("unroll") for (int m = 0; m < 4; ++m) _Pragma("unroll") for (int n = 0; n < 2; ++n) _Pragma("unroll") for (int k = 0; k < 2; ++k) \
        acc[ai][bj][m][n] = __builtin_amdgcn_mfma_f32_16x16x32_bf16(Bt[n][k], At[m][k], acc[ai][bj][m][n], 0, 0, 0); __builtin_amdgcn_s_setprio(0); } while (0)
#define PG8_WAIT_V(n) asm volatile("s_waitcnt vmcnt(" #n ")" ::: "memory")
#define PG8_WAIT_L(n) asm volatile("s_waitcnt lgkmcnt(" #n ")" ::: "memory")
#define PG8_BAR __builtin_amdgcn_s_barrier()
#define PG8_SCHED __builtin_amdgcn_sched_barrier(0)
    Unit cur, nxt; int ui = 0;
    if (!S.next(0, cur)) return;
    f32x4 acc[2][2][4][2];
#pragma unroll
    for (int a = 0; a < 2; ++a)
#pragma unroll
        for (int b = 0; b < 2; ++b)
#pragma unroll
            for (int m = 0; m < 4; ++m)
#pragma unroll
                for (int n = 0; n < 2; ++n) acc[a][b][m][n] = (f32x4){0.f, 0.f, 0.f, 0.f};
    bf16x8 At[4][2], B0[2][2], B1[2][2];
    const char* cA = (const char*)((Epi::DUAL && cur.half) ? g.A2 : g.A) + (size_t)cur.pm * tstep; const char* cB = (const char*)((Epi::DUAL && cur.half) ? g.Bt2 : g.Bt) + (size_t)cur.pn * tstep;
    S.a_ready(cur);
    if constexpr (SP2) {
        PG8_STAGE(PG8_SB(0, 0), cB, voffB); PG8_STAGE(PG8_SB(0, 1), cB + hstep, voffB); PG8_STAGE(PG8_SA(0, 0), cA, voffA); PG8_STAGE(PG8_SA(0, 1), cA + hstep, voffA);
        if (wr == 1) PG8_BAR;
        PG8_WAIT_V(2); PG8_BAR;
        PG8_STAGE(PG8_SB(1, 0), cB + kstep, voffB); PG8_STAGE(PG8_SA(1, 0), cA + kstep, voffA); PG8_STAGE(PG8_SB(1, 1), cB + hstep + kstep, voffB);
        PG8_WAIT_V(6); PG8_BAR;
    } else {
        PG8_STAGE(PG8_SB(0, 0), cB, voffB); PG8_STAGE(PG8_SA(0, 0), cA, voffA); PG8_STAGE(PG8_SB(0, 1), cB + hstep, voffB); PG8_STAGE(PG8_SA(0, 1), cA + hstep, voffA);
        if (wr == 1) PG8_BAR;
        PG8_WAIT_V(4); PG8_BAR;
        PG8_STAGE(PG8_SB(1, 0), cB + kstep, voffB); PG8_STAGE(PG8_SA(1, 0), cA + kstep, voffA); PG8_STAGE(PG8_SB(1, 1), cB + hstep + kstep, voffB);
        PG8_WAIT_V(6); PG8_BAR;
    }
    for (;;) {
        const bool has_next = S.next(ui + 1, nxt);
        const char* nA = has_next ? (const char*)((Epi::DUAL && nxt.half) ? g.A2 : g.A) + (size_t)nxt.pm * tstep : cA; const char* nB = has_next ? (const char*)((Epi::DUAL && nxt.half) ? g.Bt2 : g.Bt) + (size_t)nxt.pn * tstep : cB;
        for (int t = 0; t < nt; t += 2) {
            const bool last = (t == nt - 2);
            const char* a1 = cA + (size_t)(t + 1) * kstep;
            const char* a2 = last ? nA : cA + (size_t)(t + 2) * kstep; const char* b2 = last ? nB : cB + (size_t)(t + 2) * kstep;
            const char* a3 = a2 + kstep; const char* b3 = b2 + kstep;
            if (last && has_next) S.a_ready(nxt);
            if constexpr (SP2) {
            PG8_LDB(B0, 0, 0); PG8_LDB(B1, 0, 1); PG8_SCHED; PG8_LDA(At, 0, 0); PG8_STAGE(PG8_SA(1, 1), a1 + hstep, voffA);
            PG8_WAIT_V(8); PG8_WAIT_L(0); PG8_BAR; PG8_MMA(0, 0, At, B0); PG8_MMA(0, 1, At, B1); PG8_BAR; PG8_SCHED;
            PG8_LDA(At, 0, 1); PG8_STAGE(PG8_SB(0, 0), b2, voffB); PG8_STAGE(PG8_SB(0, 1), b2 + hstep, voffB); PG8_STAGE(PG8_SA(0, 0), a2, voffA);
            PG8_WAIT_V(8); PG8_WAIT_L(0); PG8_BAR; PG8_MMA(1, 0, At, B0); PG8_MMA(1, 1, At, B1); PG8_BAR; PG8_SCHED;
            PG8_LDB(B0, 1, 0); PG8_LDB(B1, 1, 1); PG8_SCHED; PG8_LDA(At, 1, 0); PG8_STAGE(PG8_SA(0, 1), a2 + hstep, voffA);
            PG8_WAIT_V(8); PG8_WAIT_L(0); PG8_BAR; PG8_MMA(0, 0, At, B0); PG8_MMA(0, 1, At, B1); PG8_BAR; PG8_SCHED;
            PG8_LDA(At, 1, 1); PG8_STAGE(PG8_SB(1, 0), b3, voffB); PG8_STAGE(PG8_SB(1, 1), b3 + hstep, voffB); PG8_STAGE(PG8_SA(1, 0), a3, voffA);
            PG8_WAIT_V(8); PG8_WAIT_L(0); PG8_BAR; PG8_MMA(1, 0, At, B0); PG8_MMA(1, 1, At, B1); PG8_BAR; PG8_SCHED;
            } else {
            PG8_LDB(B0, 0, 0); PG8_SCHED; PG8_LDA(At, 0, 0); PG8_STAGE(PG8_SA(1, 1), a1 + hstep, voffA);
            PG8_WAIT_L(8); PG8_BAR; PG8_WAIT_L(0); PG8_MMA(0, 0, At, B0); PG8_BAR; PG8_SCHED;
            PG8_LDB(B1, 0, 1); PG8_STAGE(PG8_SB(0, 0), b2, voffB);
            PG8_BAR; PG8_WAIT_L(0); PG8_MMA(0, 1, At, B1); PG8_BAR;
            PG8_LDA(At, 0, 1); PG8_STAGE(PG8_SA(0, 0), a2, voffA);
            PG8_BAR; PG8_WAIT_L(0); PG8_MMA(1, 0, At, B0); PG8_BAR; PG8_SCHED;
            PG8_STAGE(PG8_SB(0, 1), b2 + hstep, voffB);
            PG8_WAIT_V(6); PG8_BAR; PG8_MMA(1, 1, At, B1); PG8_BAR;
            PG8_LDB(B0, 1, 0); PG8_SCHED; PG8_LDA(At, 1, 0); PG8_STAGE(PG8_SA(0, 1), a2 + hstep, voffA);
            PG8_WAIT_L(8); PG8_BAR; PG8_WAIT_L(0); PG8_MMA(0, 0, At, B0); PG8_BAR; PG8_SCHED;
            PG8_LDB(B1, 1, 1); PG8_STAGE(PG8_SB(1, 0), b3, voffB);
            PG8_BAR; PG8_WAIT_L(0); PG8_MMA(0, 1, At, B1); PG8_BAR;
            PG8_LDA(At, 1, 1); PG8_STAGE(PG8_SA(1, 0), a3, voffA);
            PG8_BAR; PG8_WAIT_L(0); PG8_MMA(1, 0, At, B0); PG8_BAR; PG8_SCHED;
            PG8_STAGE(PG8_SB(1, 1), b3 + hstep, voffB);
            PG8_WAIT_V(6); PG8_BAR; PG8_MMA(1, 1, At, B1); PG8_BAR;
            }
        }
        if constexpr (ALIGN_EPI) { if (wr == 0) PG8_BAR; }
#ifdef PROBE_EPI
        if constexpr (Epi::PERM && !Epi::DUAL) { E(acc, cur, wr, wc, fr, fq); asm volatile("" ::: "memory"); }
#endif
        if constexpr (!Epi::AFTER_DRAIN) { E(acc, cur, wr, wc, fr, fq); S.done(cur); }
        if (!has_next) break;
        if (!(Epi::DUAL && cur.half == 0)) {
#pragma unroll
        for (int a = 0; a < 2; ++a)
#pragma unroll
            for (int b = 0; b < 2; ++b)
#pragma unroll
                for (int m = 0; m < 4; ++m)
#pragma unroll
                    for (int n = 0; n < 2; ++n) acc[a][b][m][n] = (f32x4){0.f, 0.f, 0.f, 0.f};
        }
        cur = nxt; cA = nA; cB = nB; ++ui;
        if constexpr (ALIGN_EPI) { if (wr == 1) PG8_BAR; }
    }
    PG8_WAIT_V(0);
    if constexpr (!ALIGN_EPI) { if (wr == 0) PG8_BAR; }
    PG8_BAR;
    if constexpr (Epi::AFTER_DRAIN) { E.fused(acc, cur, wr, wc, fr, fq, lds, wid, lane); S.done(cur); }
#undef PG8_SA
#undef PG8_SB
#undef PG8_STAGE
#undef PG8_LDA
#undef PG8_LDB
#undef PG8_MMA
#undef PG8_WAIT_V
#undef PG8_WAIT_L
#undef PG8_BAR
#undef PG8_SCHED
}
}

#define LAS __attribute__((address_space(3)))
typedef unsigned short bf16;
typedef unsigned u32x4 __attribute__((ext_vector_type(4)));
typedef unsigned u32x2 __attribute__((ext_vector_type(2)));
typedef float f32x4 __attribute__((ext_vector_type(4)));
typedef float f32x16 __attribute__((ext_vector_type(16)));
typedef short bf16x8 __attribute__((ext_vector_type(8)));

constexpr int BATCH = 4, SEQ = 8192, DM = 1024, MTOK = BATCH * SEQ, DFF = 4096, NIN = 5128, NREL = 257;
constexpr int PW = 4096;
constexpr float EPS = 1e-6f, LOG2E = 1.4426950408889634f, QSCALE = 0.125f * LOG2E;
constexpr size_t MiB = 1u << 20;
constexpr size_t WS_RS = 0;
constexpr size_t WS_WF = 1 * MiB;
constexpr size_t WS_LOGF = 2 * MiB;
constexpr size_t WS_C2 = 3 * MiB;
constexpr size_t WS_W = 4 * MiB, W_LAYER = 30 * MiB;
constexpr size_t W_IN = 0, W_A = 10 * MiB, W_B = 11 * MiB, W_OUT = 12 * MiB, W_UP = 14 * MiB, W_DN = 22 * MiB;
constexpr size_t WS_XB = 64 * MiB;
constexpr size_t WS_VT = 128 * MiB;
constexpr size_t WS_P = 192 * MiB;
constexpr size_t WS_END = 448 * MiB;

__device__ __forceinline__ unsigned f2bf(float f) { unsigned u = __builtin_bit_cast(unsigned, f); return (u + 0x7fffu + ((u >> 16) & 1u)) >> 16; }
__device__ __forceinline__ unsigned pk2(float lo, float hi) { return pg8::cvt_pk_bf16(lo, hi); }
__device__ __forceinline__ float bf_lo(unsigned u) { return __builtin_bit_cast(float, u << 16); }
__device__ __forceinline__ float bf_hi(unsigned u) { return __builtin_bit_cast(float, u & 0xffff0000u); }
__device__ __forceinline__ float rstd_of(float ss) { return __builtin_amdgcn_rsqf(ss * (1.0f / 1024.0f) + EPS); }
__device__ __forceinline__ float sigmoidf_(float x) { return __builtin_amdgcn_rcpf(1.0f + __builtin_amdgcn_exp2f(-x * LOG2E)); }

struct EpiProj {
    static constexpr bool PERM = true, AFTER_DRAIN = false, DUAL = false;
    bf16* O; const float* rs;
    __device__ __forceinline__ void operator()(const pg8::f32x4 (&acc)[2][2][4][2], const pg8::Unit& u, int wr, int wc, int fr, int fq) const {
        const int row0 = u.pm * 256 + wr * 64 + fr, colt = u.pn * 256, col0 = colt + wc * 32 + 8 * fq;
        const bool gate = colt >= 2048;
        const float sc = (colt < 512 || (colt >= 1024 && colt < 1536)) ? QSCALE : 1.0f;
        float rv[8];
#pragma unroll
        for (int i = 0; i < 8; ++i) rv[i] = rs[row0 + (i >> 2) * 128 + (i & 3) * 16];
        asm volatile("" ::: "memory");
#pragma unroll
        for (int ai = 0; ai < 2; ++ai)
#pragma unroll
            for (int m = 0; m < 4; ++m) {
                const int row = row0 + ai * 128 + m * 16; const float r = rstd_of(rv[ai * 4 + m]) * sc; bf16* rowp = O + (size_t)row * PW + col0;
#pragma unroll
                for (int bj = 0; bj < 2; ++bj) { pg8::f32x4 v0 = acc[ai][bj][m][0] * r, v1 = acc[ai][bj][m][1] * r;
                    if (gate) {
#pragma unroll
                        for (int j = 0; j < 4; ++j) { v0[j] = sigmoidf_(v0[j]); v1[j] = sigmoidf_(v1[j]); } }
                    u32x4 w; w.x = pk2(v0[0], v0[1]); w.y = pk2(v0[2], v0[3]); w.z = pk2(v1[0], v1[1]); w.w = pk2(v1[2], v1[3]);
                    *(u32x4*)(rowp + bj * 128) = w; } }
    }
};
struct EpiVt {
    static constexpr bool PERM = true, AFTER_DRAIN = false, DUAL = false;
    bf16* Vt; const float* rs;
    __device__ __forceinline__ void operator()(const pg8::f32x4 (&acc)[2][2][4][2], const pg8::Unit& u, int wr, int wc, int fr, int fq) const {
        const int row0 = u.pm * 256 + wr * 64 + fr, col0 = u.pn * 256 + wc * 32 + 8 * fq;
        f32x4 rq[2][2];
#pragma unroll
        for (int bj = 0; bj < 2; ++bj) { rq[bj][0] = *(const f32x4*)(rs + col0 + bj * 128); rq[bj][1] = *(const f32x4*)(rs + col0 + bj * 128 + 4); }
        asm volatile("" ::: "memory");
#pragma unroll
        for (int bj = 0; bj < 2; ++bj) { const int tok = col0 + bj * 128; const int b = tok >> 13, s = tok & 8191;
            float r[8];
#pragma unroll
            for (int j = 0; j < 4; ++j) { r[j] = rstd_of(rq[bj][0][j]); r[4 + j] = rstd_of(rq[bj][1][j]); }
#pragma unroll
            for (int ai = 0; ai < 2; ++ai)
#pragma unroll
                for (int m = 0; m < 4; ++m) { const int j = row0 + ai * 128 + m * 16; const pg8::f32x4 v0 = acc[ai][bj][m][0], v1 = acc[ai][bj][m][1];
                    u32x4 w; w.x = pk2(v0[0] * r[0], v0[1] * r[1]); w.y = pk2(v0[2] * r[2], v0[3] * r[3]); w.z = pk2(v1[0] * r[4], v1[1] * r[5]); w.w = pk2(v1[2] * r[6], v1[3] * r[7]);
                    *(u32x4*)(Vt + ((size_t)(b * 1024 + j)) * SEQ + s) = w; } }
    }
};
template <bool FIRST> struct EpiMerge {
    static constexpr bool PERM = true, AFTER_DRAIN = false, DUAL = false;
    bf16* Mg; const bf16* G;
    __device__ __forceinline__ void operator()(const pg8::f32x4 (&acc)[2][2][4][2], const pg8::Unit& u, int wr, int wc, int fr, int fq) const {
        const int row0 = u.pm * 256 + wr * 64 + fr, col0 = u.pn * 256 + wc * 32 + 8 * fq;
#pragma unroll
        for (int ai = 0; ai < 2; ++ai) {
            u32x4 gv[4][2], ov[4][2];
#pragma unroll
            for (int m = 0; m < 4; ++m)
#pragma unroll
                for (int bj = 0; bj < 2; ++bj) { const int row = row0 + ai * 128 + m * 16, col = col0 + bj * 128;
                    gv[m][bj] = *(const u32x4*)(G + (size_t)row * PW + col);
                    if (!FIRST) ov[m][bj] = *(const u32x4*)(Mg + (size_t)row * DM + col); }
            asm volatile("" ::: "memory");
#pragma unroll
            for (int m = 0; m < 4; ++m)
#pragma unroll
                for (int bj = 0; bj < 2; ++bj) { const int row = row0 + ai * 128 + m * 16, col = col0 + bj * 128;
                    const u32x4 g = gv[m][bj];
                    const pg8::f32x4 v0 = acc[ai][bj][m][0], v1 = acc[ai][bj][m][1];
                    float o[8] = {v0[0] * bf_lo(g.x), v0[1] * bf_hi(g.x), v0[2] * bf_lo(g.y), v0[3] * bf_hi(g.y), v1[0] * bf_lo(g.z), v1[1] * bf_hi(g.z), v1[2] * bf_lo(g.w), v1[3] * bf_hi(g.w)};
                    if (!FIRST) { const u32x4 old = ov[m][bj];
                        o[0] += bf_lo(old.x); o[1] += bf_hi(old.x); o[2] += bf_lo(old.y); o[3] += bf_hi(old.y); o[4] += bf_lo(old.z); o[5] += bf_hi(old.z); o[6] += bf_lo(old.w); o[7] += bf_hi(old.w); }
                    u32x4 w; w.x = pk2(o[0], o[1]); w.y = pk2(o[2], o[3]); w.z = pk2(o[4], o[5]); w.w = pk2(o[6], o[7]);
                    *(u32x4*)(Mg + (size_t)row * DM + col) = w; }
            asm volatile("" ::: "memory");
        }
    }
};
struct EpiResid {
    static constexpr bool PERM = false, AFTER_DRAIN = false, DUAL = false;
    const float* xin; float* xout; bf16* xb; float* rsum; const float* rsc;
    __device__ __forceinline__ void operator()(const pg8::f32x4 (&acc)[2][2][4][2], const pg8::Unit& u, int wr, int wc, int fr, int fq) const {
        const int row0 = u.pm * 256 + wr * 64 + fr, col0 = u.pn * 256 + wc * 32 + 4 * fq;
#pragma unroll
        for (int ai = 0; ai < 2; ++ai) {
            f32x4 xv[4][2][2];
#pragma unroll
            for (int m = 0; m < 4; ++m)
#pragma unroll
                for (int bj = 0; bj < 2; ++bj)
#pragma unroll
                    for (int n = 0; n < 2; ++n) xv[m][bj][n] = *(const f32x4*)(xin + (size_t)(row0 + ai * 128 + m * 16) * DM + col0 + bj * 128 + n * 16);
            float rr[4];
#pragma unroll
            for (int m = 0; m < 4; ++m) rr[m] = rsc ? rsc[row0 + ai * 128 + m * 16] : 0.f;
            asm volatile("" ::: "memory");
#pragma unroll
            for (int m = 0; m < 4; ++m) { const float r1 = rstd_of(rr[m]); rr[m] = rsc ? r1 * r1 : 1.f; }
#pragma unroll
            for (int m = 0; m < 4; ++m) { const int row = row0 + ai * 128 + m * 16; float ss = 0.f;
#pragma unroll
                for (int bj = 0; bj < 2; ++bj)
#pragma unroll
                    for (int n = 0; n < 2; ++n) { const size_t off = (size_t)row * DM + col0 + bj * 128 + n * 16; f32x4 o;
#pragma unroll
                        for (int j = 0; j < 4; ++j) { o[j] = xv[m][bj][n][j] + acc[ai][bj][m][n][j] * rr[m]; ss += o[j] * o[j]; }
                        *(f32x4*)(xout + off) = o;
                        u32x2 w; w.x = pk2(o[0], o[1]); w.y = pk2(o[2], o[3]); *(u32x2*)(xb + off) = w; }
                ss += __shfl_xor(ss, 16); ss += __shfl_xor(ss, 32);
                if (fq == 0) unsafeAtomicAdd(rsum + row, ss); }
            asm volatile("" ::: "memory");
        }
    }
};
struct EpiResidNorm {
    static constexpr bool PERM = false, AFTER_DRAIN = false, DUAL = false;
    const float* xin; float* out; float* rsum; const float* rsc; const float* gfin; unsigned* cnt;
    __device__ __forceinline__ void operator()(pg8::f32x4 (&acc)[2][2][4][2], const pg8::Unit& u, int wr, int wc, int fr, int fq) const {
        const int row0 = u.pm * 256 + wr * 64 + fr, col0 = u.pn * 256 + wc * 32 + 4 * fq;
#pragma unroll
        for (int ai = 0; ai < 2; ++ai) {
            f32x4 xv[4][2][2];
#pragma unroll
            for (int m = 0; m < 4; ++m)
#pragma unroll
                for (int bj = 0; bj < 2; ++bj)
#pragma unroll
                    for (int n = 0; n < 2; ++n) xv[m][bj][n] = *(const f32x4*)(xin + (size_t)(row0 + ai * 128 + m * 16) * DM + col0 + bj * 128 + n * 16);
            float rr[4];
#pragma unroll
            for (int m = 0; m < 4; ++m) rr[m] = rsc[row0 + ai * 128 + m * 16];
            asm volatile("" ::: "memory");
#pragma unroll
            for (int m = 0; m < 4; ++m) { const float r1 = rstd_of(rr[m]); const float r2 = r1 * r1; float ss = 0.f;
#pragma unroll
                for (int bj = 0; bj < 2; ++bj)
#pragma unroll
                    for (int n = 0; n < 2; ++n) {
#pragma unroll
                        for (int j = 0; j < 4; ++j) { const float o = xv[m][bj][n][j] + acc[ai][bj][m][n][j] * r2; acc[ai][bj][m][n][j] = o; ss += o * o; } }
                ss += __shfl_xor(ss, 16); ss += __shfl_xor(ss, 32);
                if (fq == 0) unsafeAtomicAdd(rsum + row0 + ai * 128 + m * 16, ss); }
        }
        asm volatile("s_waitcnt vmcnt(0)" ::: "memory");
        unsigned* c = cnt + u.pm;
        if ((threadIdx.x & 63) == 0) __hip_atomic_fetch_add(c, 1u, __ATOMIC_RELAXED, __HIP_MEMORY_SCOPE_AGENT);
        { unsigned spins = 0; while (__hip_atomic_load(c, __ATOMIC_RELAXED, __HIP_MEMORY_SCOPE_AGENT) < 32u && ++spins < (1u << 22)) __builtin_amdgcn_s_sleep(4); }
        asm volatile("" ::: "memory");
        f32x4 gq[2][2];
#pragma unroll
        for (int bj = 0; bj < 2; ++bj)
#pragma unroll
            for (int n = 0; n < 2; ++n) gq[bj][n] = *(const f32x4*)(gfin + col0 + bj * 128 + n * 16);
        float rt[8];
#pragma unroll
        for (int i = 0; i < 8; ++i) rt[i] = __hip_atomic_load(rsum + row0 + (i >> 2) * 128 + (i & 3) * 16, __ATOMIC_RELAXED, __HIP_MEMORY_SCOPE_AGENT);
#pragma unroll
        for (int ai = 0; ai < 2; ++ai)
#pragma unroll
            for (int m = 0; m < 4; ++m) { const float r = rstd_of(rt[ai * 4 + m]);
#pragma unroll
                for (int bj = 0; bj < 2; ++bj)
#pragma unroll
                    for (int n = 0; n < 2; ++n) { const f32x4 g = gq[bj][n]; f32x4 o;
#pragma unroll
                        for (int j = 0; j < 4; ++j) o[j] = acc[ai][bj][m][n][j] * r * g[j];
                        *(f32x4*)(out + (size_t)(row0 + ai * 128 + m * 16) * DM + col0 + bj * 128 + n * 16) = o; } }
    }
};
struct EpiUp {
    static constexpr bool PERM = true, AFTER_DRAIN = false, DUAL = false;
    bf16* U; const float* rs;
    __device__ __forceinline__ void operator()(const pg8::f32x4 (&acc)[2][2][4][2], const pg8::Unit& u, int wr, int wc, int fr, int fq) const {
        const int row0 = u.pm * 256 + wr * 64 + fr, col0 = u.pn * 256 + wc * 32 + 8 * fq;
#pragma unroll
        for (int ai = 0; ai < 2; ++ai)
#pragma unroll
            for (int m = 0; m < 4; ++m) { const int row = row0 + ai * 128 + m * 16; bf16* rowp = U + (size_t)row * DFF + col0;
#pragma unroll
                for (int bj = 0; bj < 2; ++bj) { pg8::f32x4 v0 = acc[ai][bj][m][0], v1 = acc[ai][bj][m][1];
#pragma unroll
                    for (int j = 0; j < 4; ++j) { const float a = fmaxf(v0[j], 0.f), b = fmaxf(v1[j], 0.f); v0[j] = a * a; v1[j] = b * b; }
                    u32x4 w; w.x = pk2(v0[0], v0[1]); w.y = pk2(v0[2], v0[3]); w.z = pk2(v1[0], v1[1]); w.w = pk2(v1[2], v1[3]);
                    *(u32x4*)(rowp + bj * 128) = w; } }
    }
};

struct EpiMergeDual {
    static constexpr bool PERM = true, AFTER_DRAIN = false, DUAL = true;
    bf16* Mg; const bf16* P;
    __device__ __forceinline__ void operator()(pg8::f32x4 (&acc)[2][2][4][2], const pg8::Unit& u, int wr, int wc, int fr, int fq) const {
        const int row0 = u.pm * 256 + wr * 64 + fr, col0 = u.pn * 256 + wc * 32 + 8 * fq;
        if (u.half == 0) {
#pragma unroll
            for (int ai = 0; ai < 2; ++ai) {
                u32x4 ga[4][2], gb[4][2];
#pragma unroll
                for (int m = 0; m < 4; ++m)
#pragma unroll
                    for (int bj = 0; bj < 2; ++bj) { const bf16* gp = P + (size_t)(row0 + ai * 128 + m * 16) * PW + col0 + bj * 128;
                        ga[m][bj] = *(const u32x4*)(gp + 2048); gb[m][bj] = *(const u32x4*)(gp + 3072); }
#pragma unroll
                for (int m = 0; m < 4; ++m)
#pragma unroll
                    for (int bj = 0; bj < 2; ++bj) { const u32x4 a = ga[m][bj], b = gb[m][bj];
                        const float ra[8] = {bf_lo(a.x), bf_hi(a.x), bf_lo(a.y), bf_hi(a.y), bf_lo(a.z), bf_hi(a.z), bf_lo(a.w), bf_hi(a.w)};
                        const float rb[8] = {bf_lo(b.x), bf_hi(b.x), bf_lo(b.y), bf_hi(b.y), bf_lo(b.z), bf_hi(b.z), bf_lo(b.w), bf_hi(b.w)};
#pragma unroll
                        for (int j = 0; j < 4; ++j) { acc[ai][bj][m][0][j] *= ra[j] * __builtin_amdgcn_rcpf(fmaxf(rb[j], 1e-20f)); acc[ai][bj][m][1][j] *= ra[4 + j] * __builtin_amdgcn_rcpf(fmaxf(rb[4 + j], 1e-20f)); } }
            }
        } else {
#pragma unroll
            for (int ai = 0; ai < 2; ++ai) {
                u32x4 gb[4][2];
#pragma unroll
                for (int m = 0; m < 4; ++m)
#pragma unroll
                    for (int bj = 0; bj < 2; ++bj) gb[m][bj] = *(const u32x4*)(P + (size_t)(row0 + ai * 128 + m * 16) * PW + col0 + bj * 128 + 3072);
                asm volatile("" ::: "memory");
#pragma unroll
                for (int m = 0; m < 4; ++m)
#pragma unroll
                    for (int bj = 0; bj < 2; ++bj) { const u32x4 b = gb[m][bj];
                        const float rb[8] = {bf_lo(b.x), bf_hi(b.x), bf_lo(b.y), bf_hi(b.y), bf_lo(b.z), bf_hi(b.z), bf_lo(b.w), bf_hi(b.w)};
                        float o[8];
#pragma unroll
                        for (int j = 0; j < 4; ++j) { o[j] = acc[ai][bj][m][0][j] * fmaxf(rb[j], 1e-20f); o[4 + j] = acc[ai][bj][m][1][j] * fmaxf(rb[4 + j], 1e-20f); }
                        u32x4 w; w.x = pk2(o[0], o[1]); w.y = pk2(o[2], o[3]); w.z = pk2(o[4], o[5]); w.w = pk2(o[6], o[7]);
                        *(u32x4*)(Mg + (size_t)(row0 + ai * 128 + m * 16) * DM + col0 + bj * 128) = w; }
                asm volatile("" ::: "memory");
            }
        }
    }
};
#ifdef PROBE_KLOOP
struct EpiUpProbe {
    static constexpr bool PERM = true, AFTER_DRAIN = false, DUAL = true;
    bf16* U;
    __device__ __forceinline__ void operator()(pg8::f32x4 (&acc)[2][2][4][2], const pg8::Unit& u, int wr, int wc, int fr, int fq) const {
        if (u.half == 0) return;
        const int row0 = u.pm * 256 + wr * 64 + fr, col0 = u.pn * 256 + wc * 32 + 8 * fq;
#pragma unroll
        for (int ai = 0; ai < 2; ++ai)
#pragma unroll
            for (int m = 0; m < 4; ++m) { const int row = row0 + ai * 128 + m * 16; bf16* rowp = U + (size_t)row * DFF + col0;
#pragma unroll
                for (int bj = 0; bj < 2; ++bj) { pg8::f32x4 v0 = acc[ai][bj][m][0] * 0.5f, v1 = acc[ai][bj][m][1] * 0.5f;
#pragma unroll
                    for (int j = 0; j < 4; ++j) { const float a = fmaxf(v0[j], 0.f), b = fmaxf(v1[j], 0.f); v0[j] = a * a; v1[j] = b * b; }
                    u32x4 w; w.x = pk2(v0[0], v0[1]); w.y = pk2(v0[2], v0[3]); w.z = pk2(v1[0], v1[1]); w.w = pk2(v1[2], v1[3]);
                    *(u32x4*)(rowp + bj * 128) = w; } }
    }
};
#endif
struct DualOrder {
    pg8::StaticOrder b;
    __device__ void init(int M, int N, int G_, int c_) { b.init(M, N, G_, c_); }
    __device__ bool next(int i, pg8::Unit& u) const { if (!b.next(i >> 1, u)) return false; u.half = i & 1; return true; }
    __device__ __forceinline__ void a_ready(const pg8::Unit&) const {}
    __device__ __forceinline__ void done(const pg8::Unit&) const {}
};

constexpr int KPITCH = 144;
constexpr int AB_K = 0, AB_V = 64 * KPITCH, AB_C = 2 * 64 * KPITCH, AB_SZ = AB_C + 256, AT_TAB = 2 * AB_SZ;
constexpr float AT_SKIP = 40.f, AT_THR = 8.f;
constexpr int AT_OST = AT_TAB + 1040 + 64, AT_OPITCH = 144;
constexpr int AT_FLAGS = AT_TAB + 1040;
__device__ __forceinline__ float max3f_(float a, float b, float c) { float r; asm("v_max3_f32 %0, %1, %2, %3" : "=v"(r) : "v"(a), "v"(b), "v"(c)); return r; }
__device__ __forceinline__ int crow(int r, int hi) { return (r & 3) + 8 * (r >> 2) + 4 * hi; }

template <bool FOX>
__device__ __forceinline__ void at_qk(f32x16& S0, f32x16& S1, const bf16x8 (&qr)[4], LAS unsigned char* kb, LAS float* tab, int t, int cq, int w, int r32, int hi) {
    if (FOX) {
#pragma unroll
        for (int g = 0; g < 4; ++g) { const f32x4 c0 = *(const LAS f32x4*)(kb + AB_C + (8 * g + 4 * hi) * 4), c1 = *(const LAS f32x4*)(kb + AB_C + (32 + 8 * g + 4 * hi) * 4);
#pragma unroll
            for (int j = 0; j < 4; ++j) { S0[4 * g + j] = c0[j]; S1[4 * g + j] = c1[j]; } }
    } else if (t >= cq - 2) {
        const int dbase = 64 * (cq - t) + (w & 1) * 32 + r32; const LAS float* pbase = tab + (dbase + 5 - 4 * hi);
#pragma unroll
        for (int r = 0; r < 16; ++r) { S0[r] = pbase[59 - ((r & 3) + 8 * (r >> 2))]; S1[r] = pbase[27 - ((r & 3) + 8 * (r >> 2))]; }
    } else { const float bf = tab[255];
#pragma unroll
        for (int r = 0; r < 16; ++r) { S0[r] = bf; S1[r] = bf; } }
#pragma unroll
    for (int ds = 0; ds < 4; ++ds) {
        const bf16x8 a0 = *(const LAS bf16x8*)(kb + AB_K + r32 * KPITCH + ds * 32 + hi * 16);
        const bf16x8 a1 = *(const LAS bf16x8*)(kb + AB_K + (32 + r32) * KPITCH + ds * 32 + hi * 16);
        S0 = __builtin_amdgcn_mfma_f32_32x32x16_bf16(a0, qr[ds], S0, 0, 0, 0);
        S1 = __builtin_amdgcn_mfma_f32_32x32x16_bf16(a1, qr[ds], S1, 0, 0, 0);
    }
#ifdef PROBE_MFMA
    { f32x16 D0 = {}, D1 = {};
#pragma unroll
      for (int ds = 0; ds < 4; ++ds) {
        const bf16x8 a0 = *(const LAS bf16x8*)(kb + AB_K + r32 * KPITCH + ds * 32 + hi * 16);
        const bf16x8 a1 = *(const LAS bf16x8*)(kb + AB_K + (32 + r32) * KPITCH + ds * 32 + hi * 16);
        D0 = __builtin_amdgcn_mfma_f32_32x32x16_bf16(a0, qr[ds], D0, 0, 0, 0);
        D1 = __builtin_amdgcn_mfma_f32_32x32x16_bf16(a1, qr[ds], D1, 0, 0, 0); }
      asm volatile("" :: "v"(D0), "v"(D1)); }
#endif
    if (FOX && t == cq) { const int qrel = (w & 1) * 32 + r32;
#pragma unroll
        for (int r = 0; r < 16; ++r) { const int kv = crow(r, hi); if (kv > qrel) S0[r] = -1e30f; if (kv + 32 > qrel) S1[r] = -1e30f; } }
}
__device__ __forceinline__ void at_pv(f32x16& o0, f32x16& o1, const u32x4 (&pw)[4], LAS unsigned char* vb, int r32, int hi) {
#pragma unroll
    for (int ks = 0; ks < 4; ++ks) {
        const bf16x8 v0 = *(const LAS bf16x8*)(vb + AB_V + r32 * KPITCH + (16 * ks + 8 * hi) * 2);
        const bf16x8 v1 = *(const LAS bf16x8*)(vb + AB_V + (32 + r32) * KPITCH + (16 * ks + 8 * hi) * 2);
        o0 = __builtin_amdgcn_mfma_f32_32x32x16_bf16(v0, __builtin_bit_cast(bf16x8, pw[ks]), o0, 0, 0, 0);
        o1 = __builtin_amdgcn_mfma_f32_32x32x16_bf16(v1, __builtin_bit_cast(bf16x8, pw[ks]), o1, 0, 0, 0);
    }
}
__device__ __forceinline__ bool at_softmax(f32x16& S0, f32x16& S1, float& mref, float& lrun, float& alpha_pend, bool& resc_pend, u32x4 (&pw)[4]) {
    float mx = fmaxf(S0[0], S1[0]), mx2 = fmaxf(S0[1], S1[1]);
#pragma unroll
    for (int r = 2; r < 16; r += 2) { mx = max3f_(mx, S0[r], S1[r]); mx2 = max3f_(mx2, S0[r + 1], S1[r + 1]); }
    mx = fmaxf(mx, mx2);
    mx = fmaxf(mx, __shfl_xor(mx, 32));
    if (__all(mx < mref - AT_SKIP)) return true;
    if (__any(mx > mref + AT_THR)) { const float mnew = fmaxf(mref, mx), a = __builtin_amdgcn_exp2f(mref - mnew);
        lrun *= a; alpha_pend = resc_pend ? alpha_pend * a : a; resc_pend = true; mref = mnew; }
    float ls = 0.f;
#pragma unroll
    for (int r = 0; r < 16; ++r) { S0[r] = __builtin_amdgcn_exp2f(S0[r] - mref); S1[r] = __builtin_amdgcn_exp2f(S1[r] - mref); ls += S0[r] + S1[r]; }
    lrun += ls;
#ifdef PROBE_VALU
    { float dm = 0.f;
#pragma unroll
      for (int r = 0; r < 16; ++r) { dm += __builtin_amdgcn_exp2f(S0[r] - 3.f) + __builtin_amdgcn_exp2f(S1[r] - 3.f); dm = fmaxf(dm, S0[r] * S1[r]); }
      asm volatile("" :: "v"(dm)); }
#endif
    pw[0].x = pk2(S0[0], S0[1]); pw[0].y = pk2(S0[2], S0[3]); pw[0].z = pk2(S0[4], S0[5]); pw[0].w = pk2(S0[6], S0[7]);
    pw[1].x = pk2(S0[8], S0[9]); pw[1].y = pk2(S0[10], S0[11]); pw[1].z = pk2(S0[12], S0[13]); pw[1].w = pk2(S0[14], S0[15]);
    pw[2].x = pk2(S1[0], S1[1]); pw[2].y = pk2(S1[2], S1[3]); pw[2].z = pk2(S1[4], S1[5]); pw[2].w = pk2(S1[6], S1[7]);
    pw[3].x = pk2(S1[8], S1[9]); pw[3].y = pk2(S1[10], S1[11]); pw[3].z = pk2(S1[12], S1[13]); pw[3].w = pk2(S1[14], S1[15]);
    return false;
}

struct AtState { float mref, lrun, alpha_pend, smax; bool resc_pend, pv_pend, wave_done, hvx, hvy; };
template <bool FOX, bool GRPB>
__device__ __forceinline__ bool at_interval(int k, int NT, int t1, int cq, int w, int r32, int hi, int lane, int tid, int srow, int sch,
                                            f32x16& X0, f32x16& X1, f32x16& Y0, f32x16& Y1, f32x16& o0, f32x16& o1, u32x4 (&pw)[4], AtState& st, bool& hvX, bool& hvY,
                                            u32x4& ldk, u32x4& ldv, float& ldc, const u32x4& stk, const u32x4& stv, const float& stc,
                                            const bf16x8 (&qr)[4], LAS unsigned char* lds, LAS float* tab, const bf16* kg, const bf16* vg, const float* cgp) {
    LAS unsigned char* rb = lds + ((k + 1) & 1) * AB_SZ;
    LAS unsigned char* wb = lds + (k & 1) * AB_SZ;
    const bool has2 = k + 2 < NT;
    if (k + 3 < NT) { const int t = t1 - (k + 3); ldk = *(const u32x4*)(kg + (size_t)t * 64 * PW); if (FOX) ldc = cgp[(size_t)t * 64]; }
    if (k + 1 < NT) { const int t = t1 - (k + 1); ldv = *(const u32x4*)(vg + (size_t)t * 64); }
    const int tn = t1 - (k + 1);
    const bool act_n = (k + 1 < NT) && (FOX ? (tn <= cq) : (tn >= cq - 8 && tn <= cq)) && !st.wave_done;
    if (!GRPB) {
        if (act_n) { at_qk<FOX>(Y0, Y1, qr, rb, tab, tn, cq, w, r32, hi); hvY = true; }
        if (st.resc_pend) {
#pragma unroll
            for (int r = 0; r < 16; ++r) { o0[r] *= st.alpha_pend; o1[r] *= st.alpha_pend; }
            st.resc_pend = false; }
        if (st.pv_pend) at_pv(o0, o1, pw, rb, r32, hi);
        st.pv_pend = false;
        if (hvX) { st.pv_pend = !at_softmax(X0, X1, st.mref, st.lrun, st.alpha_pend, st.resc_pend, pw); hvX = false; }
    } else {
        if (hvY) { st.pv_pend = !at_softmax(Y0, Y1, st.mref, st.lrun, st.alpha_pend, st.resc_pend, pw); hvY = false; }
        if (st.resc_pend) {
#pragma unroll
            for (int r = 0; r < 16; ++r) { o0[r] *= st.alpha_pend; o1[r] *= st.alpha_pend; }
            st.resc_pend = false; }
        if (st.pv_pend) at_pv(o0, o1, pw, rb, r32, hi);
        st.pv_pend = false;
        if (act_n) { at_qk<FOX>(Y0, Y1, qr, rb, tab, tn, cq, w, r32, hi); hvY = true; }
    }
    LAS unsigned* flags = (LAS unsigned*)(lds + AT_FLAGS);
    if (FOX) {
        if (k + 1 < NT) { const float cb = *(const LAS float*)(rb + AB_C + 63 * 4); if (__all(st.smax + cb < st.mref - AT_SKIP)) st.wave_done = true; }
        if (lane == 0) flags[(k & 1) * 8 + w] = st.wave_done ? 1u : 0u; }
    if (has2) { *(LAS u32x4*)(wb + AB_K + srow * KPITCH + sch * 16) = stk; if (FOX && tid < 64) *(LAS float*)(wb + AB_C + tid * 4) = -stc; }
    { const int pa = 16 * (sch >> 1) + 4 * (sch & 1); u32x2 va; va.x = stv.x; va.y = stv.y; u32x2 vb; vb.x = stv.z; vb.y = stv.w;
      *(LAS u32x2*)(wb + AB_V + srow * KPITCH + pa * 2) = va; *(LAS u32x2*)(wb + AB_V + srow * KPITCH + (pa + 8) * 2) = vb; }
#ifdef PROBE_BAR
    asm volatile("s_waitcnt lgkmcnt(0)\n\ts_barrier" ::: "memory");
#endif
    asm volatile("s_waitcnt lgkmcnt(0)\n\ts_barrier" ::: "memory");
    if (k + 1 >= NT) return true;
    if (FOX) { const u32x4 f0 = *(const LAS u32x4*)(flags + (k & 1) * 8), f1 = *(const LAS u32x4*)(flags + (k & 1) * 8 + 4);
        const unsigned all = f0.x & f0.y & f0.z & f0.w & f1.x & f1.y & f1.z & f1.w;
        if (__builtin_amdgcn_readfirstlane(all) != 0u) return true; }
    return false;
}
template <bool FOX, bool GRPB>
__device__ __forceinline__ void at_walk(int NT, int t1, int cq, int w, int r32, int hi, int lane, int tid, int srow, int sch, f32x16& o0, f32x16& o1, AtState& st,
                                        const bf16x8 (&qr)[4], LAS unsigned char* lds, LAS float* tab, const bf16* kg, const bf16* vg, const float* cgp) {
    f32x16 e0 = {}, e1 = {}, d0 = {}, d1 = {}; u32x4 pw[4]; bool hve = false, hvd = false;
    { const int t = t1; if (FOX ? (t <= cq) : (t >= cq - 8 && t <= cq)) { at_qk<FOX>(e0, e1, qr, lds, tab, t, cq, w, r32, hi); hve = true; } }
    __syncthreads();
    u32x4 ek = {}, ev = {}, dk = {}, dv = {}; float ec = 0.f, dc = 0.f;
    if (2 < NT) { const int t = t1 - 2; dk = *(const u32x4*)(kg + (size_t)t * 64 * PW); if (FOX) dc = cgp[(size_t)t * 64]; }
    dv = *(const u32x4*)(vg + (size_t)t1 * 64);
    int k = 0;
    for (;;) {
        if (at_interval<FOX, GRPB>(k, NT, t1, cq, w, r32, hi, lane, tid, srow, sch, e0, e1, d0, d1, o0, o1, pw, st, hve, hvd, ek, ev, ec, dk, dv, dc, qr, lds, tab, kg, vg, cgp)) break;
        ++k;
        if (at_interval<FOX, GRPB>(k, NT, t1, cq, w, r32, hi, lane, tid, srow, sch, d0, d1, e0, e1, o0, o1, pw, st, hvd, hve, dk, dv, dc, ek, ev, ec, qr, lds, tab, kg, vg, cgp)) break;
        ++k;
    }
    asm volatile("s_waitcnt vmcnt(0)" ::: "memory");
    if (GRPB) { if (k & 1) { if (hvd) st.pv_pend = !at_softmax(d0, d1, st.mref, st.lrun, st.alpha_pend, st.resc_pend, pw); }
                else       { if (hve) st.pv_pend = !at_softmax(e0, e1, st.mref, st.lrun, st.alpha_pend, st.resc_pend, pw); } }
    if (st.resc_pend) {
#pragma unroll
        for (int r = 0; r < 16; ++r) { o0[r] *= st.alpha_pend; o1[r] *= st.alpha_pend; } }
    if (st.pv_pend) at_pv(o0, o1, pw, lds + (k & 1) * AB_SZ, r32, hi);
}

template <bool FOX>
__device__ __forceinline__ void attn_unit(LAS unsigned char* lds, int b, int h, int qb, const bf16* __restrict__ P, const bf16* __restrict__ Vt,
                                          const float* __restrict__ c2, const float* __restrict__ relb, bf16* __restrict__ O, float kn) {
    int tid_l = threadIdx.x; asm volatile("" : "+v"(tid_l));
    const int tid = tid_l, lane = tid & 63, r32 = lane & 31, hi = lane >> 5;
    const int w = __builtin_amdgcn_readfirstlane(tid >> 6);
    constexpr int QOFF = FOX ? 0 : 1024, KOFF = FOX ? 512 : 1536, VOFF = FOX ? 0 : 512;
    const size_t tokq = (size_t)b * SEQ + qb * 256 + w * 32 + r32;
    bf16x8 qr[4];
    { const bf16* qp = P + tokq * PW + QOFF + h * 64 + hi * 8;
#pragma unroll
      for (int ds = 0; ds < 4; ++ds) qr[ds] = *(const bf16x8*)(qp + ds * 16); }
    AtState st; st.mref = -1e30f; st.lrun = 0.f; st.alpha_pend = 1.f; st.smax = 0.f; st.resc_pend = false; st.pv_pend = false; st.wave_done = false; st.hvx = false; st.hvy = false;
    if (FOX) { float q2 = 0.f;
#pragma unroll
        for (int ds = 0; ds < 4; ++ds) { const u32x4 qu = __builtin_bit_cast(u32x4, qr[ds]);
            q2 += bf_lo(qu.x) * bf_lo(qu.x) + bf_hi(qu.x) * bf_hi(qu.x) + bf_lo(qu.y) * bf_lo(qu.y) + bf_hi(qu.y) * bf_hi(qu.y)
                + bf_lo(qu.z) * bf_lo(qu.z) + bf_hi(qu.z) * bf_hi(qu.z) + bf_lo(qu.w) * bf_lo(qu.w) + bf_hi(qu.w) * bf_hi(qu.w); }
        q2 += __shfl_xor(q2, 32); st.smax = sqrtf(q2) * kn * 1.01f + 0.01f; }
    const int t1 = 4 * qb + 3, t0 = FOX ? 0 : (4 * qb - 8 > 0 ? 4 * qb - 8 : 0), NT = t1 - t0 + 1;
    const int cq = 4 * qb + (w >> 1);
    const int srow = tid >> 3, sch = tid & 7;
    const bf16* kg = P + ((size_t)b * SEQ + srow) * PW + KOFF + h * 64 + sch * 8;
    const bf16* vg = Vt + ((size_t)(b * 1024 + VOFF + h * 64 + srow)) * SEQ + sch * 8;
    const float* cgp = c2 + (size_t)(b * 8 + h) * SEQ + (tid & 63);
    LAS float* tab = (LAS float*)(lds + AT_TAB);
    if (!FOX) { if (tid < 256) tab[tid] = relb[tid + 64 < 256 ? tid + 64 : 256] * LOG2E; }
#pragma unroll
    for (int i = 0; i < 2; ++i) if (i < NT) { const int t = t1 - i; LAS unsigned char* bb = lds + i * AB_SZ;
        const u32x4 kreg = *(const u32x4*)(kg + (size_t)t * 64 * PW); *(LAS u32x4*)(bb + AB_K + srow * KPITCH + sch * 16) = kreg;
        if (FOX && tid < 64) *(LAS float*)(bb + AB_C + tid * 4) = -cgp[(size_t)t * 64]; }
    __syncthreads();
    f32x16 o0 = {}, o1 = {};
    if (w >= 4) __builtin_amdgcn_s_setprio(1);
    if (w < 4) at_walk<FOX, false>(NT, t1, cq, w, r32, hi, lane, tid, srow, sch, o0, o1, st, qr, lds, tab, kg, vg, cgp);
    else       at_walk<FOX, true >(NT, t1, cq, w, r32, hi, lane, tid, srow, sch, o0, o1, st, qr, lds, tab, kg, vg, cgp);
    __builtin_amdgcn_s_setprio(0);
    float lrun = st.lrun;
    lrun += __shfl_xor(lrun, 32);
    const float inv = __builtin_amdgcn_rcpf(lrun);
    { LAS unsigned char* ost = lds + AT_OST + w * (32 * AT_OPITCH);
#pragma unroll
      for (int g = 0; g < 4; ++g) {
        u32x2 a; a.x = pk2(o0[4 * g] * inv, o0[4 * g + 1] * inv); a.y = pk2(o0[4 * g + 2] * inv, o0[4 * g + 3] * inv);
        u32x2 c; c.x = pk2(o1[4 * g] * inv, o1[4 * g + 1] * inv); c.y = pk2(o1[4 * g + 2] * inv, o1[4 * g + 3] * inv);
        *(LAS u32x2*)(ost + r32 * AT_OPITCH + (8 * g + 4 * hi) * 2) = a; *(LAS u32x2*)(ost + r32 * AT_OPITCH + (32 + 8 * g + 4 * hi) * 2) = c; }
      asm volatile("s_waitcnt lgkmcnt(0)" ::: "memory");
      bf16* ob = O + ((size_t)b * SEQ + qb * 256 + w * 32) * 512 + h * 64;
#pragma unroll
      for (int i = 0; i < 4; ++i) { const int row = i * 8 + (lane >> 3), ch = lane & 7;
        const u32x4 v = *(const LAS u32x4*)(ost + row * AT_OPITCH + ch * 16); *(u32x4*)(ob + (size_t)row * 512 + ch * 8) = v; } }
    __syncthreads();
}


__device__ __forceinline__ float wave_sum(float v) {
#pragma unroll
    for (int o = 1; o < 64; o <<= 1) v += __shfl_xor(v, o);
    return v;
}
__device__ __forceinline__ void transpose_item(const float* __restrict__ W, int ldw, const float* __restrict__ gk, bf16* __restrict__ WT, int ldt, int dest_row0, int src_col0, int k0, LAS float* scr, int lane) {
#pragma unroll
    for (int i = 0; i < 32; ++i) { const int kk = 2 * i + (lane >> 5); float v = W[(size_t)(k0 + kk) * ldw + src_col0 + (lane & 31)]; if (gk) v *= gk[k0 + kk]; scr[kk * 33 + (lane & 31)] = v; }
    asm volatile("s_waitcnt lgkmcnt(0)" ::: "memory");
    const int c = lane & 7;
#pragma unroll
    for (int j = 0; j < 4; ++j) { const int n = (lane >> 3) + 8 * j; const LAS float* s = scr + (8 * c) * 33 + n;
        u32x4 o; o.x = pk2(s[0 * 33], s[1 * 33]); o.y = pk2(s[2 * 33], s[3 * 33]); o.z = pk2(s[4 * 33], s[5 * 33]); o.w = pk2(s[6 * 33], s[7 * 33]);
        *(u32x4*)(WT + (size_t)(dest_row0 + n) * ldt + k0 + 8 * c) = o; }
    asm volatile("s_waitcnt lgkmcnt(0)" ::: "memory");
}
__device__ __forceinline__ void ti_load(const float* __restrict__ W, int ldw, int src_col0, int k0, int lane, float (&v)[32]) {
#pragma unroll
    for (int i = 0; i < 32; ++i) { const int kk = 2 * i + (lane >> 5); v[i] = W[(size_t)(k0 + kk) * ldw + src_col0 + (lane & 31)]; }
}
__device__ __forceinline__ void ti_finish(const float (&v)[32], const float* __restrict__ gk, bf16* __restrict__ WT, int ldt, int dest_row0, int k0, LAS float* scr, int lane) {
    const int c = lane & 7;
    f32x4 g0 = {1.f, 1.f, 1.f, 1.f}, g1 = {1.f, 1.f, 1.f, 1.f};
    if (gk) { g0 = *(const f32x4*)(gk + k0 + 8 * c); g1 = *(const f32x4*)(gk + k0 + 8 * c + 4); }
#pragma unroll
    for (int i = 0; i < 32; ++i) { const int kk = 2 * i + (lane >> 5); scr[kk * 33 + (lane & 31)] = v[i]; }
    asm volatile("s_waitcnt lgkmcnt(0)" ::: "memory");
#pragma unroll
    for (int j = 0; j < 4; ++j) { const int n = (lane >> 3) + 8 * j; const LAS float* s = scr + (8 * c) * 33 + n;
        u32x4 o; o.x = pk2(s[0 * 33] * g0.x, s[1 * 33] * g0.y); o.y = pk2(s[2 * 33] * g0.z, s[3 * 33] * g0.w); o.z = pk2(s[4 * 33] * g1.x, s[5 * 33] * g1.y); o.w = pk2(s[6 * 33] * g1.z, s[7 * 33] * g1.w);
        *(u32x4*)(WT + (size_t)(dest_row0 + n) * ldt + k0 + 8 * c) = o; }
    asm volatile("s_waitcnt lgkmcnt(0)" ::: "memory");
}
__device__ __forceinline__ int win_src_col(int d) {
    if (d < 1024) return d;
    if (d < 1536) return 1544 + (d - 1024);
    if (d < 2048) return 2056 + (d - 1536);
    if (d < 4096) return 3080 + (d - 2048);
    if (d < 4608) return 1024 + (d - 4096);
    return 2568 + (d - 4608);
}

#define XB_TMO      128
#define XB_XCNT(j)  (256  + 64 * (j))
#define XB_XSUB(j)  (1280 + 64 * (j))
#define XB_XGEN(j)  (2304 + 64 * (j))
#define XB_TOP      3328
#define XB_TOPGEN   3392
#define XCD_BAR_WORDS 3456
#define XB_SPIN_CAP (1u << 18)

__device__ __forceinline__ unsigned xb_ld(unsigned* p)              { return __hip_atomic_load(p, __ATOMIC_RELAXED, __HIP_MEMORY_SCOPE_AGENT); }
__device__ __forceinline__ unsigned xb_add(unsigned* p, unsigned v) { return __hip_atomic_fetch_add(p, v, __ATOMIC_RELAXED, __HIP_MEMORY_SCOPE_AGENT); }
__device__ __forceinline__ unsigned xb_xcc_id() { return (unsigned)__builtin_amdgcn_s_getreg((3 << 11) | 20) & 0xFu; }
#define XB_SPIN(cond, bar) do { unsigned _sp = 0; while (cond) { __builtin_amdgcn_s_sleep(1); \
    if ((++_sp & 255u) == 0u) { if (xb_ld(&(bar)[XB_TMO])) break; if (_sp > XB_SPIN_CAP) { atomicAdd(&(bar)[XB_TMO], 1u); break; } } } } while (0)

struct XcdBarrier {
    unsigned* bar; unsigned x;
    volatile LAS unsigned* st;
};

__device__ __forceinline__ XcdBarrier xcd_barrier_post(unsigned* bar, volatile LAS unsigned* st) {
    XcdBarrier b; b.bar = bar; b.x = xb_xcc_id(); b.st = st;
    if (threadIdx.x == 0) (void)xb_add(&bar[XB_XCNT(b.x)], 1u);
    return b;
}
__device__ __forceinline__ void xcd_barrier_complete(unsigned* bar, unsigned x, unsigned& nloc, unsigned& nx) {
    const unsigned G = gridDim.x * gridDim.y * gridDim.z;
    unsigned sum, cnt, mine, sp = 0u;
    for (;;) {
        sum = 0u; cnt = 0u; mine = 0u;
#pragma unroll
        for (unsigned j = 0; j < 16; ++j) { const unsigned c = xb_ld(&bar[XB_XCNT(j)]); sum += c; cnt += (c > 0u) ? 1u : 0u; mine = (j == x) ? c : mine; }
        if (sum == G) break;
        __builtin_amdgcn_s_sleep(1);
        if ((++sp & 255u) == 0u) { if (xb_ld(&bar[XB_TMO])) break; if (sp > XB_SPIN_CAP) { atomicAdd(&bar[XB_TMO], 1u); break; } }
    }
    nloc = mine > 0u ? mine : 1u; nx = cnt > 0u ? cnt : 1u;
}

__device__ __forceinline__ void xcd_barrier(const XcdBarrier& b) {
    asm volatile("s_waitcnt vmcnt(0)" ::: "memory");
    __syncthreads();
    if (threadIdx.x == 0) {
        unsigned* bar = b.bar;
        __builtin_amdgcn_s_waitcnt(0);
        unsigned nloc = b.st[0], nx = b.st[1];
        if (nloc == 0u) { xcd_barrier_complete(bar, b.x, nloc, nx); b.st[0] = nloc; b.st[1] = nx; }
        const unsigned old = xb_add(&bar[XB_XSUB(b.x)], 1u);
        const unsigned gen = old / nloc;
        if (old + 1u == (gen + 1u) * nloc) {
            __builtin_amdgcn_fence(__ATOMIC_RELEASE, "agent");
            asm volatile("s_waitcnt vmcnt(0)" ::: "memory");
            const unsigned og = xb_add(&bar[XB_TOP], 1u);
            const unsigned tg = og / nx;
            if (og + 1u == (tg + 1u) * nx) xb_add(&bar[XB_TOPGEN], 1u);
            else XB_SPIN(xb_ld(&bar[XB_TOPGEN]) == tg, bar);
            __builtin_amdgcn_fence(__ATOMIC_ACQUIRE, "agent");
            xb_add(&bar[XB_XGEN(b.x)], 1u);
            asm volatile("s_waitcnt vmcnt(0)" ::: "memory");
        } else {
            XB_SPIN(xb_ld(&bar[XB_XGEN(b.x)]) == gen, bar);
            __builtin_amdgcn_fence(__ATOMIC_ACQUIRE, "agent");
            asm volatile("s_waitcnt vmcnt(0)" ::: "memory");
        }
    }
    __syncthreads();
}

constexpr size_t WS_MISC = 800 * 1024;
constexpr size_t WS_BAR = 768 * 1024;
#ifndef PHMASK
#define PHMASK 0xffff
#endif
struct Params { const float* in[12]; float* out; unsigned char* ws; int ph_lo, ph_hi; };

__global__ void __launch_bounds__(512, 2) mega_fwd(Params p) {
    extern __shared__ __attribute__((aligned(16))) unsigned char lds_raw[];
    LAS unsigned char* lds = (LAS unsigned char*)lds_raw;
    cg::grid_group grid = cg::this_grid();
    volatile LAS unsigned* bar_st = (volatile LAS unsigned*)(lds + 131072);
    if (threadIdx.x == 0) { bar_st[0] = 0u; bar_st[1] = 0u; }
    __syncthreads();
    (void)xcd_barrier_post((unsigned*)(p.ws + WS_BAR), bar_st);
    if (p.ph_hi > 1000) grid.sync();
    for (int pc = p.ph_lo; pc < p.ph_hi; ++pc) {
        int ph = pc;
#ifdef PROBE_K
        if (pc >= 1 && pc <= 16) { const int l_ = (pc - 1) / 8, j_ = (pc - 1) % 8; ph = 1 + 7 * l_ + (j_ <= PROBE_K ? j_ : j_ - 1); } else if (pc == 17) ph = 15;
#endif
#ifdef PROBE_SYNCS
        if (pc == 2) { for (int i_ = 0; i_ < PROBE_SYNCS; ++i_) { XcdBarrier xb_; xb_.bar = (unsigned*)(pp->ws + WS_BAR); xb_.x = xb_xcc_id(); xb_.st = bar_st; xcd_barrier(xb_); } }
#endif
        int G = gridDim.x, bx = blockIdx.x; asm volatile("" : "+s"(G), "+s"(bx));
#define PH_BEGIN int tid = threadIdx.x; asm volatile("" : "+v"(tid)); const int lane = tid & 63, wave = __builtin_amdgcn_readfirstlane(tid >> 6); const int gw = bx * 8 + wave, NGW = G * 8; (void)lane; (void)gw; (void)NGW;
        typedef const __attribute__((address_space(4))) Params* kparams_t;
        kparams_t pp = (kparams_t)__builtin_amdgcn_kernarg_segment_ptr(); asm volatile("" : "+s"(pp));
        unsigned char* ws = pp->ws;
#define x_in (pp->in[0])
#define norm1 (pp->in[1])
#define w_in (pp->in[2])
#define fbias (pp->in[3])
#define relb (pp->in[4])
#define w_a (pp->in[5])
#define w_b (pp->in[6])
#define w_out (pp->in[7])
#define norm2 (pp->in[8])
#define w_up (pp->in[9])
#define w_dn (pp->in[10])
#define fnorm (pp->in[11])
#define X (pp->out)
        float* RS = (float*)(ws + WS_RS); float* WF = (float*)(ws + WS_WF); float* LOGF = (float*)(ws + WS_LOGF); float* C2B = (float*)(ws + WS_C2);
        bf16* XB = (bf16*)(ws + WS_XB); bf16* OA = XB; bf16* OB = XB + (size_t)MTOK * 512;
        bf16* VT = (bf16*)(ws + WS_VT); bf16* MG = VT; bf16* PB = (bf16*)(ws + WS_P); bf16* UB = PB;
        if ((PHMASK & 1) && ph == 0) { PH_BEGIN
            LAS float* scr = (LAS float*)(lds + wave * 16384);
            constexpr int I_IN = 16 * 160, I_A = 8 * 32, I_O = 16 * 32, I_UP = 16 * 128, I_DN = 64 * 32, NIT = I_IN + 2 * I_A + I_O + I_UP + I_DN;
#define TI_DEC(IT, W_, ldw_, gk_, WT_, ldt_, dr_, sc_, k0_) do { const int l_ = (IT) / NIT; int r_ = (IT) % NIT; unsigned char* wl_ = ws + WS_W + l_ * W_LAYER; \
                if (r_ < I_IN) { const int kb = r_ / 160, nb = r_ % 160; W_ = w_in + (size_t)l_ * DM * NIN; ldw_ = NIN; gk_ = norm1 + l_ * DM; WT_ = (bf16*)(wl_ + W_IN); ldt_ = DM; dr_ = 32 * nb; sc_ = win_src_col(32 * nb); k0_ = 64 * kb; } \
                else if ((r_ -= I_IN) < I_A) { const int kb = r_ / 32, nb = r_ % 32; W_ = w_a + (size_t)l_ * 512 * DM; ldw_ = DM; gk_ = nullptr; WT_ = (bf16*)(wl_ + W_A); ldt_ = 512; dr_ = 32 * nb; sc_ = 32 * nb; k0_ = 64 * kb; } \
                else if ((r_ -= I_A) < I_A) { const int kb = r_ / 32, nb = r_ % 32; W_ = w_b + (size_t)l_ * 512 * DM; ldw_ = DM; gk_ = nullptr; WT_ = (bf16*)(wl_ + W_B); ldt_ = 512; dr_ = 32 * nb; sc_ = 32 * nb; k0_ = 64 * kb; } \
                else if ((r_ -= I_A) < I_O) { const int kb = r_ / 32, nb = r_ % 32; W_ = w_out + (size_t)l_ * DM * DM; ldw_ = DM; gk_ = nullptr; WT_ = (bf16*)(wl_ + W_OUT); ldt_ = DM; dr_ = 32 * nb; sc_ = 32 * nb; k0_ = 64 * kb; } \
                else if ((r_ -= I_O) < I_UP) { const int kb = r_ / 128, nb = r_ % 128; W_ = w_up + (size_t)l_ * DM * DFF; ldw_ = DFF; gk_ = norm2 + l_ * DM; WT_ = (bf16*)(wl_ + W_UP); ldt_ = DM; dr_ = 32 * nb; sc_ = 32 * nb; k0_ = 64 * kb; } \
                else { r_ -= I_UP; const int kb = r_ / 32, nb = r_ % 32; W_ = w_dn + (size_t)l_ * DFF * DM; ldw_ = DM; gk_ = nullptr; WT_ = (bf16*)(wl_ + W_DN); ldt_ = DFF; dr_ = 32 * nb; sc_ = 32 * nb; k0_ = 64 * kb; } } while (0)
            for (int it = gw; it < 2 * NIT; it += 4 * NGW) {
                const bool hb = it + NGW < 2 * NIT, hc = it + 2 * NGW < 2 * NIT, hd = it + 3 * NGW < 2 * NIT;
                const float* Wa; const float* ga; bf16* Ta; int lwa, lta, dra, sca, k0a; TI_DEC(it, Wa, lwa, ga, Ta, lta, dra, sca, k0a);
                const float* Wb; const float* gb; bf16* Tb; int lwb, ltb, drb, scb, k0b; TI_DEC((hb ? it + NGW : it), Wb, lwb, gb, Tb, ltb, drb, scb, k0b);
                const float* Wc; const float* gc; bf16* Tc; int lwc, ltc, drc, scc, k0c; TI_DEC((hc ? it + 2 * NGW : it), Wc, lwc, gc, Tc, ltc, drc, scc, k0c);
                const float* Wd; const float* gd; bf16* Td; int lwd, ltd, drd, scd, k0d; TI_DEC((hd ? it + 3 * NGW : it), Wd, lwd, gd, Td, ltd, drd, scd, k0d);
                float va[32], vb[32], vc[32], vd[32];
                ti_load(Wa, lwa, sca, k0a, lane, va);
                ti_load(Wb, lwb, scb, k0b, lane, vb);
                ti_load(Wc, lwc, scc, k0c, lane, vc);
                ti_load(Wd, lwd, scd, k0d, lane, vd);
                ti_finish(va, ga, Ta, lta, dra, k0a, scr, lane);
                if (hb) ti_finish(vb, gb, Tb, ltb, drb, k0b, scr, lane);
                if (hc) ti_finish(vc, gc, Tc, ltc, drc, k0c, scr, lane);
                if (hd) ti_finish(vd, gd, Td, ltd, drd, k0d, scr, lane);
            }
#undef TI_DEC
            for (int i = bx * 512 + tid; i < 2 * 8 * 1024; i += G * 512) { const int l = i >> 13, hh = (i >> 10) & 7, k = i & 1023; WF[i] = w_in[(size_t)l * DM * NIN + (size_t)k * NIN + 1536 + hh] * norm1[l * DM + k]; }
            for (int i = bx * 512 + tid; i < 4 * MTOK; i += G * 512) RS[MTOK + i] = 0.f;
            for (int m = gw; m < MTOK; m += 4 * NGW) {
                f32x4 vx[4][4]; float sx[4]; int mr[4];
#pragma unroll
                for (int r = 0; r < 4; ++r) { const int mm = m + r * NGW; mr[r] = mm < MTOK ? mm : m;
                    const f32x4* xp = (const f32x4*)(x_in + (size_t)mr[r] * DM) + lane;
#pragma unroll
                    for (int j = 0; j < 4; ++j) vx[r][j] = xp[64 * j]; }
#pragma unroll
                for (int r = 0; r < 4; ++r) { float s = 0.f;
#pragma unroll
                    for (int j = 0; j < 4; ++j) s += (vx[r][j].x * vx[r][j].x + vx[r][j].y * vx[r][j].y) + (vx[r][j].z * vx[r][j].z + vx[r][j].w * vx[r][j].w);
                    sx[r] = wave_sum(s); }
#pragma unroll
                for (int r = 0; r < 4; ++r) { if (m + r * NGW < MTOK) { u32x2* op = (u32x2*)(XB + (size_t)mr[r] * DM) + lane;
#pragma unroll
                        for (int j = 0; j < 4; ++j) { u32x2 w2; w2.x = pk2(vx[r][j].x, vx[r][j].y); w2.y = pk2(vx[r][j].z, vx[r][j].w); op[64 * j] = w2; }
                        if (lane == 0) RS[mr[r]] = sx[r]; } }
            }
        } else if ((PHMASK & 256) && ph == 15) { PH_BEGIN
            const float* rs = RS + 4 * MTOK;
            f32x4 gq[4];
#pragma unroll
            for (int j = 0; j < 4; ++j) gq[j] = ((const f32x4*)fnorm)[lane + 64 * j];
            for (int m = gw; m < MTOK; m += 2 * NGW) {
                const int m2 = m + NGW; const bool has2 = m2 < MTOK;
                f32x4* xa = (f32x4*)(X + (size_t)m * DM) + lane; f32x4* xc = (f32x4*)(X + (size_t)(has2 ? m2 : m) * DM) + lane;
                f32x4 va[4], vc[4];
#pragma unroll
                for (int j = 0; j < 4; ++j) { va[j] = xa[64 * j]; vc[j] = xc[64 * j]; }
                const float ra = rstd_of(rs[m]), rc = rstd_of(rs[has2 ? m2 : m]);
                asm volatile("" ::: "memory");
#pragma unroll
                for (int j = 0; j < 4; ++j) { f32x4 o; o.x = va[j].x * ra * gq[j].x; o.y = va[j].y * ra * gq[j].y; o.z = va[j].z * ra * gq[j].z; o.w = va[j].w * ra * gq[j].w; xa[64 * j] = o; }
                if (has2) {
#pragma unroll
                    for (int j = 0; j < 4; ++j) { f32x4 o; o.x = vc[j].x * rc * gq[j].x; o.y = vc[j].y * rc * gq[j].y; o.z = vc[j].z * rc * gq[j].z; o.w = vc[j].w * rc * gq[j].w; xc[64 * j] = o; } }
            }
        } else {
            const int l = (ph - 1) / 7, k = (ph - 1) % 7;
            unsigned char* wl = ws + WS_W + l * W_LAYER;
            const float* rs1 = RS + (size_t)(2 * l) * MTOK; float* rs2 = RS + (size_t)(2 * l + 1) * MTOK; float* rs3 = RS + (size_t)(2 * l + 2) * MTOK;
            if ((PHMASK & 2) && k == 0) { PH_BEGIN
                { pg8::Gemm g{XB, (const bf16*)(wl + W_IN), MTOK, 4096, DM, nullptr, nullptr}; pg8::StaticOrder S; S.init(MTOK, 4096, G, bx); EpiProj E{PB, rs1};
                  pg8::gemm_phase<EpiProj, pg8::StaticOrder, true, true>(lds, g, S, E); }
                { pg8::Gemm g{(const bf16*)(wl + W_IN) + (size_t)4096 * DM, XB, 1024, MTOK, DM, nullptr, nullptr}; pg8::StaticOrder S; S.init(1024, MTOK, G, bx); EpiVt E{VT, rs1};
                  pg8::gemm_phase<EpiVt, pg8::StaticOrder, true, true>(lds, g, S, E); }
                LAS float* wfl = (LAS float*)lds;
                for (int i = tid; i < 8 * 1024; i += 512) wfl[i] = WF[l * 8192 + i];
                __syncthreads();
                u32x4 nx[2][2] = {};
#pragma unroll
                for (int rr = 0; rr < 2; ++rr) { const int mr = gw + rr * NGW; if (mr < MTOK) { nx[rr][0] = *(const u32x4*)(XB + (size_t)mr * DM + 8 * lane); nx[rr][1] = *(const u32x4*)(XB + (size_t)mr * DM + 512 + 8 * lane); } }
                for (int m0 = gw; m0 < MTOK; m0 += 2 * NGW) {
                  u32x4 cu[2][2];
#pragma unroll
                  for (int rr = 0; rr < 2; ++rr) { cu[rr][0] = nx[rr][0]; cu[rr][1] = nx[rr][1]; }
#pragma unroll
                  for (int rr = 0; rr < 2; ++rr) { const int mr = m0 + (2 + rr) * NGW; if (mr < MTOK) { nx[rr][0] = *(const u32x4*)(XB + (size_t)mr * DM + 8 * lane); nx[rr][1] = *(const u32x4*)(XB + (size_t)mr * DM + 512 + 8 * lane); } }
#pragma unroll
                  for (int rr = 0; rr < 2; ++rr) { const int m = m0 + rr * NGW; if (m < MTOK) {
                    const u32x4 xa = cu[rr][0], xc = cu[rr][1];
                    float xv[16] = {bf_lo(xa.x), bf_hi(xa.x), bf_lo(xa.y), bf_hi(xa.y), bf_lo(xa.z), bf_hi(xa.z), bf_lo(xa.w), bf_hi(xa.w),
                                    bf_lo(xc.x), bf_hi(xc.x), bf_lo(xc.y), bf_hi(xc.y), bf_lo(xc.z), bf_hi(xc.z), bf_lo(xc.w), bf_hi(xc.w)};
                    const float r = rstd_of(rs1[m]); float dd[8];
#pragma unroll
                    for (int hh = 0; hh < 8; ++hh) { const LAS f32x4* wp = (const LAS f32x4*)(wfl + hh * 1024 + 8 * lane); const f32x4 w0 = wp[0], w1 = wp[1], w2 = wp[128], w3 = wp[129];
                        dd[hh] = xv[0] * w0.x + xv[1] * w0.y + xv[2] * w0.z + xv[3] * w0.w + xv[4] * w1.x + xv[5] * w1.y + xv[6] * w1.z + xv[7] * w1.w
                               + xv[8] * w2.x + xv[9] * w2.y + xv[10] * w2.z + xv[11] * w2.w + xv[12] * w3.x + xv[13] * w3.y + xv[14] * w3.z + xv[15] * w3.w; }
                    float e4[4], e2[2], mine;
                    { const bool up = (lane & 32) != 0;
#pragma unroll
                      for (int j = 0; j < 4; ++j) { const float keep = up ? dd[4 + j] : dd[j], send = up ? dd[j] : dd[4 + j]; e4[j] = keep + __shfl_xor(send, 32); } }
                    { const bool up = (lane & 16) != 0;
#pragma unroll
                      for (int j = 0; j < 2; ++j) { const float keep = up ? e4[2 + j] : e4[j], send = up ? e4[j] : e4[2 + j]; e2[j] = keep + __shfl_xor(send, 16); } }
                    { const bool up = (lane & 8) != 0; const float keep = up ? e2[1] : e2[0], send = up ? e2[0] : e2[1]; mine = keep + __shfl_xor(send, 8); }
                    mine += __shfl_xor(mine, 4); mine += __shfl_xor(mine, 2); mine += __shfl_xor(mine, 1);
                    if ((lane & 7) == 0) { const int hh = lane >> 3; const float z = mine * r + fbias[l * 8 + hh]; const float az = fabsf(z);
                        const float ls = fminf(z, 0.f) - log1pf(__expf(-az));
                        const int b = m >> 13, s = m & 8191; LOGF[(size_t)(b * 8 + hh) * SEQ + s] = ls * LOG2E; }
                  } }
                }
            } else if ((PHMASK & 4) && k == 1) { PH_BEGIN
                int sq0 = bx, sq1 = 32, sqs = G;
                if (G == 256) { if ((bx & 31) < 2) { const int j_ = (bx >> 5) * 2 + (bx & 1); sq0 = 2 * j_; sq1 = 2 * j_ + 2; } else { sq0 = 0; sq1 = 0; } sqs = 1; }
                for (int sq = sq0; sq < sq1; sq += sqs) {
                    const f32x4* src = (const f32x4*)(LOGF + (size_t)sq * SEQ) + tid * 4; f32x4 v[4]; float run = 0.f;
#pragma unroll
                    for (int j = 0; j < 4; ++j) { v[j] = src[j]; v[j].x += run; v[j].y += v[j].x; v[j].z += v[j].y; v[j].w += v[j].z; run = v[j].w; }
                    float inc = run;
#pragma unroll
                    for (int o = 1; o < 64; o <<= 1) { const float t = __shfl_up(inc, o); if (lane >= o) inc += t; }
                    LAS float* wt = (LAS float*)lds;
                    if (lane == 63) wt[wave] = inc;
                    __syncthreads();
                    float off = inc - run;
                    for (int ww = 0; ww < wave; ++ww) off += wt[ww];
                    f32x4* dst = (f32x4*)(C2B + (size_t)sq * SEQ) + tid * 4;
#pragma unroll
                    for (int j = 0; j < 4; ++j) { v[j].x += off; v[j].y += off; v[j].z += off; v[j].w += off; dst[j] = v[j]; }
                    __syncthreads();
                }
                for (int ti = bx; ti < 256; ti += G) {
                    const int bh = ti >> 3, part = ti & 7; float mxv = 0.f;
#pragma unroll
                    for (int rr = 0; rr < 16; ++rr) { const int srw = part * 1024 + rr * 64 + (tid >> 3);
                        const u32x4 kv = *(const u32x4*)(PB + ((size_t)(bh >> 3) * SEQ + srw) * PW + 512 + (bh & 7) * 64 + (tid & 7) * 8);
                        float s2 = bf_lo(kv.x) * bf_lo(kv.x) + bf_hi(kv.x) * bf_hi(kv.x) + bf_lo(kv.y) * bf_lo(kv.y) + bf_hi(kv.y) * bf_hi(kv.y)
                                 + bf_lo(kv.z) * bf_lo(kv.z) + bf_hi(kv.z) * bf_hi(kv.z) + bf_lo(kv.w) * bf_lo(kv.w) + bf_hi(kv.w) * bf_hi(kv.w);
                        s2 += __shfl_xor(s2, 1); s2 += __shfl_xor(s2, 2); s2 += __shfl_xor(s2, 4);
                        mxv = fmaxf(mxv, s2); }
#pragma unroll
                    for (int o = 8; o < 64; o <<= 1) mxv = fmaxf(mxv, __shfl_xor(mxv, o));
                    if (lane == 0) atomicMax((unsigned*)(ws + WS_MISC) + l * 32 + bh, __builtin_bit_cast(unsigned, sqrtf(mxv))); }
                for (int ui = bx; ui < 1024; ui += G) { const int bh = ui >> 5, qb = ui & 31;
                    attn_unit<false>(lds, bh >> 3, bh & 7, qb, PB, VT, C2B, relb + (size_t)(l * 8 + (bh & 7)) * NREL, OB, 0.f); }
            } else if ((PHMASK & 8) && k == 2) {
                { int tid_q = threadIdx.x; asm volatile("" : "+v"(tid_q));
                  LAS unsigned* qslot = (LAS unsigned*)(lds + 131072 + 64);
                  unsigned* qhead = (unsigned*)(ws + WS_MISC) + 64 + pc;   const unsigned* knp = (const unsigned*)(ws + WS_MISC) + l * 32;
                  for (;;) {
                      if (tid_q == 0) *qslot = atomicAdd(qhead, 1u);
                      __syncthreads();
                      const int ui = (int)__builtin_amdgcn_readfirstlane(*qslot);
                      __syncthreads();
                      if (ui >= 1024) break;
                      const int bh = ui & 31, qb = 31 - (ui >> 5);
                      attn_unit<true>(lds, bh >> 3, bh & 7, qb, PB, VT, C2B, relb, OA, __builtin_bit_cast(float, knp[bh])); } }
            } else if ((PHMASK & 16) && k == 3) {
                { pg8::Gemm g{OA, (const bf16*)(wl + W_A), MTOK, DM, 512, OB, (const bf16*)(wl + W_B)}; DualOrder S; S.init(MTOK, DM, G, bx); EpiMergeDual E{MG, PB};
                  pg8::gemm_phase<EpiMergeDual, DualOrder, true, true>(lds, g, S, E); }
            } else if ((PHMASK & 32) && k == 4) {
                pg8::Gemm g{MG, (const bf16*)(wl + W_OUT), MTOK, DM, DM, nullptr, nullptr}; pg8::StaticOrder S; S.init(MTOK, DM, G, bx); EpiResid E{l == 0 ? x_in : X, X, XB, rs2, nullptr};
                pg8::gemm_phase<EpiResid, pg8::StaticOrder, true, true>(lds, g, S, E);
            } else if ((PHMASK & 64) && k == 5) {
#ifdef PROBE_KLOOP
                pg8::Gemm g{XB, (const bf16*)(wl + W_UP), MTOK, DFF, DM, XB, (const bf16*)(wl + W_UP)}; DualOrder S; S.init(MTOK, DFF, G, bx); EpiUpProbe E{UB};
                pg8::gemm_phase<EpiUpProbe, DualOrder, true, true>(lds, g, S, E);
#else
                pg8::Gemm g{XB, (const bf16*)(wl + W_UP), MTOK, DFF, DM, nullptr, nullptr}; pg8::StaticOrder S; S.init(MTOK, DFF, G, bx); EpiUp E{UB, rs2};
                pg8::gemm_phase<EpiUp, pg8::StaticOrder, true, true>(lds, g, S, E);
#endif
            } else if (PHMASK & 128) {
                pg8::Gemm g{UB, (const bf16*)(wl + W_DN), MTOK, DM, DFF, nullptr, nullptr}; pg8::StaticOrder S; S.init(MTOK, DM, G, bx);
                if (l == 1 && G == 256) { EpiResidNorm E{X, X, rs3, rs2, fnorm, (unsigned*)(ws + WS_MISC) + 128};
                    pg8::gemm_phase<EpiResidNorm, pg8::StaticOrder, true, true>(lds, g, S, E); }
                else { EpiResid E{X, X, XB, rs3, rs2};
                    pg8::gemm_phase<EpiResid, pg8::StaticOrder, true, true>(lds, g, S, E); }
            }
        }
        if (pc + 1 < p.ph_hi) {
            XcdBarrier xb_; xb_.bar = (unsigned*)(pp->ws + WS_BAR); xb_.x = xb_xcc_id(); xb_.st = bar_st; xcd_barrier(xb_);
        }
    }
}

constexpr int LDS_BYTES = 135168;

extern "C" void kernel_launch(void* const* d_in, const int* in_sizes, int n_in, void* d_out, int out_size, void* d_ws, size_t ws_size, hipStream_t stream) {
    static int grid_blocks = 0;
    if (grid_blocks == 0) {
        if (n_in != 12 || out_size != MTOK * DM || ws_size < WS_END) { fprintf(stderr, "kernel_launch: unexpected shapes (n_in %d out %d ws %zu)\n", n_in, out_size, ws_size); grid_blocks = -1; return; }
        int dev = 0, cus = 0, per_cu = 0;
        hipGetDevice(&dev);
        hipDeviceGetAttribute(&cus, hipDeviceAttributeMultiprocessorCount, dev);
        if (hipFuncSetAttribute((const void*)mega_fwd, hipFuncAttributeMaxDynamicSharedMemorySize, LDS_BYTES) != hipSuccess) { fprintf(stderr, "kernel_launch: hipFuncSetAttribute failed\n"); grid_blocks = -1; return; }
        if (hipOccupancyMaxActiveBlocksPerMultiprocessor(&per_cu, (const void*)mega_fwd, 512, LDS_BYTES) != hipSuccess || per_cu < 1) { fprintf(stderr, "kernel_launch: occupancy query gave %d\n", per_cu); per_cu = 1; (void)hipGetLastError(); }
        grid_blocks = cus * per_cu;
    }
    if (grid_blocks < 0) return;
    Params p{};
    for (int i = 0; i < 12; ++i) p.in[i] = (const float*)d_in[i];
    p.out = (float*)d_out; p.ws = (unsigned char*)d_ws; p.ph_lo = 0;
#ifdef PROBE_K
    p.ph_hi = 18;
#else
    p.ph_hi = (grid_blocks == 256) ? 15 : 16;
#endif
    if (hipMemsetAsync((char*)d_ws + WS_BAR, 0, WS_MISC + 1024 - WS_BAR, stream) != hipSuccess) { fprintf(stderr, "kernel_launch: hipMemsetAsync failed\n"); return; }
    void* args[] = {&p};
    hipError_t e = hipLaunchCooperativeKernel((const void*)mega_fwd, dim3(grid_blocks), dim3(512), args, LDS_BYTES, stream);
    if (e != hipSuccess) fprintf(stderr, "cooperative launch failed: %s (grid %d)\n", hipGetErrorString(e), grid_blocks);
}
```

```cpp
#include <hip/hip_runtime.h>
#include <hip/hip_cooperative_groups.h>
#include <cstdio>
#include <cstdint>
namespace cg = cooperative_groups;
namespace pg8 {
#define PG8_LAS __attribute__((address_space(3)))
typedef unsigned short bf16_t;
typedef short bf16x8 __attribute__((ext_vector_type(8)));
typedef float f32x4 __attribute__((ext_vector_type(4)));
typedef unsigned u32x4 __attribute__((ext_vector_type(4)));
constexpr int BM = 256, BK = 64, HALF = 128, HTB = HALF * BK * 2  , STAGE_BYTES = 8 * HTB, NXCD = 8, WGM = 8;

__host__ __device__ __forceinline__ int lds_byte(int r, int c) { const int st = (r >> 4) * 2 + (c >> 5), rr = r & 15, cc = c & 31, ob = rr * 64 + cc * 2; return st * 1024 + (ob ^ (((ob >> 9) & 1) << 5)); }
__host__ __device__ __forceinline__ void stage_rc(int b, int& R, int& C) { const int st = b / 1024, sb = b % 1024, swz = sb ^ (((sb >> 9) & 1) << 5); R = (st >> 1) * 16 + swz / 64; C = (st & 1) * 32 + (swz % 64) / 2; }
__host__ __device__ __forceinline__ int perm32(int rho) { const int n = rho >> 4, i = rho & 15; return 8 * (i >> 2) + 4 * n + (i & 3); }

struct Unit { int pm, pn, half; };
struct Gemm { const bf16_t* A; const bf16_t* Bt; int M, N, K; const bf16_t* A2; const bf16_t* Bt2; };

struct StaticOrder {
    int nM, nN, nwg, G, c;
    __host__ __device__ void init(int M, int N, int G_, int c_) { nM = M / BM; nN = N / BM; nwg = nM * nN; G = G_; c = c_; }
    __host__ __device__ bool next(int i, Unit& u) const {
        const long L = (long)i * G + c; if (L >= nwg) return false;
        int wgid = (int)L; { const int q = nwg / NXCD, r = nwg % NXCD, xcd = wgid % NXCD, off = wgid / NXCD; wgid = (xcd < r ? xcd * (q + 1) : r * (q + 1) + (xcd - r) * q) + off; }
        const int nig = WGM * nN, gid = wgid / nig, fm = gid * WGM, gsz = (nM - fm) < WGM ? (nM - fm) : WGM;
        u.pm = fm + ((wgid % nig) % gsz); u.pn = (wgid % nig) / gsz; return true;
    }
    __device__ __forceinline__ void a_ready(const Unit&) const {}
    __device__ __forceinline__ void done(const Unit&) const {}
};

__device__ __forceinline__ unsigned cvt_pk_bf16(float lo, float hi) { unsigned r; asm volatile("v_cvt_pk_bf16_f32 %0, %1, %2" : "=v"(r) : "v"(lo), "v"(hi)); return r; }
typedef float f32x2 __attribute__((ext_vector_type(2)));
template <class Epi, class Sched, bool ALIGN_EPI = false, bool SP2 = false>
__device__ __forceinline__ void gemm_phase(PG8_LAS unsigned char* lds, const Gemm g, const Sched& S, const Epi& E) {
    int tid_l = threadIdx.x; asm volatile("" : "+v"(tid_l));
    const int tid = tid_l, wid = __builtin_amdgcn_readfirstlane(tid >> 6), lane = tid & 63, wr = wid >> 2, wc = wid & 3, fr = lane & 15, fq = lane >> 4;
    const int K = g.K, nt = K / BK;
    unsigned voffA[2], voffB[2];
#pragma unroll
    for (int i = 0; i < 2; ++i) { int R, C; stage_rc(tid * 16 + i * 8192, R, C); const int Rb = Epi::PERM ? ((R & ~31) + perm32(R & 31)) : R;
        voffA[i] = (unsigned)(R * K + C) * 2u; voffB[i] = (unsigned)(Rb * K + C) * 2u; }
    const size_t kstep = (size_t)(BK * 2);
    const size_t hstep = (size_t)HALF * K * 2;
    const size_t tstep = 2 * hstep;
    const unsigned ldsw = (unsigned)wid * 1024u;
    const int aoff = lds_byte(wr * 64 + fr, fq * 8), boff = lds_byte(wc * 32 + fr, fq * 8);
#define PG8_SA(b, h) (((b) * 2 + (h)) * HTB)
#define PG8_SB(b, h) ((4 + (b) * 2 + (h)) * HTB)
#define PG8_STAGE(bufoff, gbase, voff) do { _Pragma("unroll") for (int _i = 0; _i < 2; ++_i) \
        __builtin_amdgcn_global_load_lds((const unsigned*)((const char*)(gbase) + (voff)[_i]), (PG8_LAS unsigned*)(lds + (bufoff) + ldsw + _i * 8192), 16, 0, 0); } while (0)
#define PG8_LDA(dst, b, h) do { _Pragma("unroll") for (int m = 0; m < 4; ++m) _Pragma("unroll") for (int k = 0; k < 2; ++k) dst[m][k] = *(const PG8_LAS bf16x8*)(lds + PG8_SA(b, h) + aoff + m * 2048 + k * 1024); } while (0)
#define PG8_LDB(dst, b, h) do { _Pragma("unroll") for (int n = 0; n < 2; ++n) _Pragma("unroll") for (int k = 0; k < 2; ++k) dst[n][k] = *(const PG8_LAS bf16x8*)(lds + PG8_SB(b, h) + boff + n * 2048 + k * 1024); } while (0)
#define PG8_MMA(ai, bj, At, Bt) do { __builtin_amdgcn_s_setprio(1); _Pragma("unroll") for (int m = 0; m < 4; ++m) _Pragma("unroll") for (int n = 0; n < 2; ++n) _Pragma("unroll") for (int k = 0; k < 2; ++k) \
        acc[ai][bj][m][n] = __builtin_amdgcn_mfma_f32_16x16x32_bf16(Bt[n][k], At[m][k], acc[ai][bj][m][n], 0, 0, 0); __builtin_amdgcn_s_setprio(0); } while (0)
#define PG8_WAIT_V(n) asm volatile("s_waitcnt vmcnt(" #n ")" ::: "memory")
#define PG8_WAIT_L(n) asm volatile("s_waitcnt lgkmcnt(" #n ")" ::: "memory")
#define PG8_BAR __builtin_amdgcn_s_barrier()
#define PG8_SCHED __builtin_amdgcn_sched_barrier(0)
    Unit cur, nxt; int ui = 0;
    if (!S.next(0, cur)) return;
    f32x4 acc[2][2][4][2];
#pragma unroll
    for (int a = 0; a < 2; ++a)
#pragma unroll
        for (int b = 0; b < 2; ++b)
#pragma unroll
            for (int m = 0; m < 4; ++m)
#pragma unroll
                for (int n = 0; n < 2; ++n) acc[a][b][m][n] = (f32x4){0.f, 0.f, 0.f, 0.f};
    bf16x8 At[4][2], B0[2][2], B1[2][2];
    const char* cA = (const char*)((Epi::DUAL && cur.half) ? g.A2 : g.A) + (size_t)cur.pm * tstep; const char* cB = (const char*)((Epi::DUAL && cur.half) ? g.Bt2 : g.Bt) + (size_t)cur.pn * tstep;
    S.a_ready(cur);
    if constexpr (SP2) {
        PG8_STAGE(PG8_SB(0, 0), cB, voffB); PG8_STAGE(PG8_SB(0, 1), cB + hstep, voffB); PG8_STAGE(PG8_SA(0, 0), cA, voffA); PG8_STAGE(PG8_SA(0, 1), cA + hstep, voffA);
        if (wr == 1) PG8_BAR;
        PG8_WAIT_V(2); PG8_BAR;
        PG8_STAGE(PG8_SB(1, 0), cB + kstep, voffB); PG8_STAGE(PG8_SA(1, 0), cA + kstep, voffA); PG8_STAGE(PG8_SB(1, 1), cB + hstep + kstep, voffB);
        PG8_WAIT_V(6); PG8_BAR;
    } else {
        PG8_STAGE(PG8_SB(0, 0), cB, voffB); PG8_STAGE(PG8_SA(0, 0), cA, voffA); PG8_STAGE(PG8_SB(0, 1), cB + hstep, voffB); PG8_STAGE(PG8_SA(0, 1), cA + hstep, voffA);
        if (wr == 1) PG8_BAR;
        PG8_WAIT_V(4); PG8_BAR;
        PG8_STAGE(PG8_SB(1, 0), cB + kstep, voffB); PG8_STAGE(PG8_SA(1, 0), cA + kstep, voffA); PG8_STAGE(PG8_SB(1, 1), cB + hstep + kstep, voffB);
        PG8_WAIT_V(6); PG8_BAR;
    }
    for (;;) {
        const bool has_next = S.next(ui + 1, nxt);
        const char* nA = has_next ? (const char*)((Epi::DUAL && nxt.half) ? g.A2 : g.A) + (size_t)nxt.pm * tstep : cA; const char* nB = has_next ? (const char*)((Epi::DUAL && nxt.half) ? g.Bt2 : g.Bt) + (size_t)nxt.pn * tstep : cB;
        for (int t = 0; t < nt; t += 2) {
            const bool last = (t == nt - 2);
            const char* a1 = cA + (size_t)(t + 1) * kstep;
            const char* a2 = last ? nA : cA + (size_t)(t + 2) * kstep; const char* b2 = last ? nB : cB + (size_t)(t + 2) * kstep;
            const char* a3 = a2 + kstep; const char* b3 = b2 + kstep;
            if (last && has_next) S.a_ready(nxt);
            if constexpr (SP2) {
            PG8_LDB(B0, 0, 0); PG8_LDB(B1, 0, 1); PG8_SCHED; PG8_LDA(At, 0, 0); PG8_STAGE(PG8_SA(1, 1), a1 + hstep, voffA);
            PG8_WAIT_V(8); PG8_WAIT_L(0); PG8_BAR; PG8_MMA(0, 0, At, B0); PG8_MMA(0, 1, At, B1); PG8_BAR; PG8_SCHED;
            PG8_LDA(At, 0, 1); PG8_STAGE(PG8_SB(0, 0), b2, voffB); PG8_STAGE(PG8_SB(0, 1), b2 + hstep, voffB); PG8_STAGE(PG8_SA(0, 0), a2, voffA);
            PG8_WAIT_V(8); PG8_WAIT_L(0); PG8_BAR; PG8_MMA(1, 0, At, B0); PG8_MMA(1, 1, At, B1); PG8_BAR; PG8_SCHED;
            PG8_LDB(B0, 1, 0); PG8_LDB(B1, 1, 1); PG8_SCHED; PG8_LDA(At, 1, 0); PG8_STAGE(PG8_SA(0, 1), a2 + hstep, voffA);
            PG8_WAIT_V(8); PG8_WAIT_L(0); PG8_BAR; PG8_MMA(0, 0, At, B0); PG8_MMA(0, 1, At, B1); PG8_BAR; PG8_SCHED;
            PG8_LDA(At, 1, 1); PG8_STAGE(PG8_SB(1, 0), b3, voffB); PG8_STAGE(PG8_SB(1, 1), b3 + hstep, voffB); PG8_STAGE(PG8_SA(1, 0), a3, voffA);
            PG8_WAIT_V(8); PG8_WAIT_L(0); PG8_BAR; PG8_MMA(1, 0, At, B0); PG8_MMA(1, 1, At, B1); PG8_BAR; PG8_SCHED;
            } else {
            PG8_LDB(B0, 0, 0); PG8_SCHED; PG8_LDA(At, 0, 0); PG8_STAGE(PG8_SA(1, 1), a1 + hstep, voffA);
            PG8_WAIT_L(8); PG8_BAR; PG8_WAIT_L(0); PG8_MMA(0, 0, At, B0); PG8_BAR; PG8_SCHED;
            PG8_LDB(B1, 0, 1); PG8_STAGE(PG8_SB(0, 0), b2, voffB);
            PG8_BAR; PG8_WAIT_L(0); PG8_MMA(0, 1, At, B1); PG8_BAR;
            PG8_LDA(At, 0, 1); PG8_STAGE(PG8_SA(0, 0), a2, voffA);
            PG8_BAR; PG8_WAIT_L(0); PG8_MMA(1, 0, At, B0); PG8_BAR; PG8_SCHED;
            PG8_STAGE(PG8_SB(0, 1), b2 + hstep, voffB);
            PG8_WAIT_V(6); PG8_BAR; PG8_MMA(1, 1, At, B1); PG8_BAR;
            PG8_LDB(B0, 1, 0); PG8_SCHED; PG8_LDA(At, 1, 0); PG8_STAGE(PG8_SA(0, 1), a2 + hstep, voffA);
            PG8_WAIT_L(8); PG8_BAR; PG8_WAIT_L(0); PG8_MMA(0, 0, At, B0); PG8_BAR; PG8_SCHED;
            PG8_LDB(B1, 1, 1); PG8_STAGE(PG8_SB(1, 0), b3, voffB);
            PG8_BAR; PG8_WAIT_L(0); PG8_MMA(0, 1, At, B1); PG8_BAR;
            PG8_LDA(At, 1, 1); PG8_STAGE(PG8_SA(1, 0), a3, voffA);
            PG8_BAR; PG8_WAIT_L(0); PG8_MMA(1, 0, At, B0); PG8_BAR; PG8_SCHED;
            PG8_STAGE(PG8_SB(1, 1), b3 + hstep, voffB);
            PG8_WAIT_V(6); PG8_BAR; PG8_MMA(1, 1, At, B1); PG8_BAR;
            }
        }
        if constexpr (ALIGN_EPI) { if (wr == 0) PG8_BAR; }
#ifdef PROBE_EPI
        if constexpr (Epi::PERM && !Epi::DUAL) { E(acc, cur, wr, wc, fr, fq); asm volatile("" ::: "memory"); }
#endif
        if constexpr (!Epi::AFTER_DRAIN) { E(acc, cur, wr, wc, fr, fq); S.done(cur); }
        if (!has_next) break;
        if (!(Epi::DUAL && cur.half == 0)) {
#pragma unroll
        for (int a = 0; a < 2; ++a)
#pragma unroll
            for (int b = 0; b < 2; ++b)
#pragma unroll
                for (int m = 0; m < 4; ++m)
#pragma unroll
                    for (int n = 0; n < 2; ++n) acc[a][b][m][n] = (f32x4){0.f, 0.f, 0.f, 0.f};
        }
        cur = nxt; cA = nA; cB = nB; ++ui;
        if constexpr (ALIGN_EPI) { if (wr == 1) PG8_BAR; }
    }
    PG8_WAIT_V(0);
    if constexpr (!ALIGN_EPI) { if (wr == 0) PG8_BAR; }
    PG8_BAR;
    if constexpr (Epi::AFTER_DRAIN) { E.fused(acc, cur, wr, wc, fr, fq, lds, wid, lane); S.done(cur); }
#undef PG8_SA
#undef PG8_SB
#undef PG8_STAGE
#undef PG8_LDA
#undef PG8_LDB
#undef PG8_MMA
#undef PG8_WAIT_V
#undef PG8_WAIT_L
#undef PG8_BAR
#undef PG8_SCHED
}
}

#define LAS __attribute__((address_space(3)))
typedef unsigned short bf16;
typedef unsigned u32x4 __attribute__((ext_vector_type(4)));
typedef unsigned u32x2 __attribute__((ext_vector_type(2)));
typedef float f32x4 __attribute__((ext_vector_type(4)));
typedef float f32x16 __attribute__((ext_vector_type(16)));
typedef short bf16x8 __attribute__((ext_vector_type(8)));

constexpr int BATCH = 4, SEQ = 8192, DM = 1024, MTOK = BATCH * SEQ, DFF = 4096, NIN = 5128, NREL = 257;
constexpr int PW = 4096;
constexpr float EPS = 1e-6f, LOG2E = 1.4426950408889634f, QSCALE = 0.125f * LOG2E;
constexpr size_t MiB = 1u << 20;
constexpr size_t WS_RS = 0;
constexpr size_t WS_WF = 1 * MiB;
constexpr size_t WS_LOGF = 2 * MiB;
constexpr size_t WS_C2 = 3 * MiB;
constexpr size_t WS_W = 4 * MiB, W_LAYER = 30 * MiB;
constexpr size_t W_IN = 0, W_A = 10 * MiB, W_B = 11 * MiB, W_OUT = 12 * MiB, W_UP = 14 * MiB, W_DN = 22 * MiB;
constexpr size_t WS_XB = 64 * MiB;
constexpr size_t WS_VT = 128 * MiB;
constexpr size_t WS_P = 192 * MiB;
constexpr size_t WS_END = 448 * MiB;

__device__ __forceinline__ unsigned f2bf(float f) { unsigned u = __builtin_bit_cast(unsigned, f); return (u + 0x7fffu + ((u >> 16) & 1u)) >> 16; }
__device__ __forceinline__ unsigned pk2(float lo, float hi) { return pg8::cvt_pk_bf16(lo, hi); }
__device__ __forceinline__ float bf_lo(unsigned u) { return __builtin_bit_cast(float, u << 16); }
__device__ __forceinline__ float bf_hi(unsigned u) { return __builtin_bit_cast(float, u & 0xffff0000u); }
__device__ __forceinline__ float rstd_of(float ss) { return __builtin_amdgcn_rsqf(ss * (1.0f / 1024.0f) + EPS); }
__device__ __forceinline__ float sigmoidf_(float x) { return __builtin_amdgcn_rcpf(1.0f + __builtin_amdgcn_exp2f(-x * LOG2E)); }

struct EpiProj {
    static constexpr bool PERM = true, AFTER_DRAIN = false, DUAL = false;
    bf16* O; const float* rs;
    __device__ __forceinline__ void operator()(const pg8::f32x4 (&acc)[2][2][4][2], const pg8::Unit& u, int wr, int wc, int fr, int fq) const {
        const int row0 = u.pm * 256 + wr * 64 + fr, colt = u.pn * 256, col0 = colt + wc * 32 + 8 * fq;
        const bool gate = colt >= 2048;
        const float sc = (colt < 512 || (colt >= 1024 && colt < 1536)) ? QSCALE : 1.0f;
        float rv[8];
#pragma unroll
        for (int i = 0; i < 8; ++i) rv[i] = rs[row0 + (i >> 2) * 128 + (i & 3) * 16];
        asm volatile("" ::: "memory");
#pragma unroll
        for (int ai = 0; ai < 2; ++ai)
#pragma unroll
            for (int m = 0; m < 4; ++m) {
                const int row = row0 + ai * 128 + m * 16; const float r = rstd_of(rv[ai * 4 + m]) * sc; bf16* rowp = O + (size_t)row * PW + col0;
#pragma unroll
                for (int bj = 0; bj < 2; ++bj) { pg8::f32x4 v0 = acc[ai][bj][m][0] * r, v1 = acc[ai][bj][m][1] * r;
                    if (gate) {
#pragma unroll
                        for (int j = 0; j < 4; ++j) { v0[j] = sigmoidf_(v0[j]); v1[j] = sigmoidf_(v1[j]); } }
                    u32x4 w; w.x = pk2(v0[0], v0[1]); w.y = pk2(v0[2], v0[3]); w.z = pk2(v1[0], v1[1]); w.w = pk2(v1[2], v1[3]);
                    *(u32x4*)(rowp + bj * 128) = w; } }
    }
};
struct EpiVt {
    static constexpr bool PERM = true, AFTER_DRAIN = false, DUAL = false;
    bf16* Vt; const float* rs;
    __device__ __forceinline__ void operator()(const pg8::f32x4 (&acc)[2][2][4][2], const pg8::Unit& u, int wr, int wc, int fr, int fq) const {
        const int row0 = u.pm * 256 + wr * 64 + fr, col0 = u.pn * 256 + wc * 32 + 8 * fq;
        f32x4 rq[2][2];
#pragma unroll
        for (int bj = 0; bj < 2; ++bj) { rq[bj][0] = *(const f32x4*)(rs + col0 + bj * 128); rq[bj][1] = *(const f32x4*)(rs + col0 + bj * 128 + 4); }
        asm volatile("" ::: "memory");
#pragma unroll
        for (int bj = 0; bj < 2; ++bj) { const int tok = col0 + bj * 128; const int b = tok >> 13, s = tok & 8191;
            float r[8];
#pragma unroll
            for (int j = 0; j < 4; ++j) { r[j] = rstd_of(rq[bj][0][j]); r[4 + j] = rstd_of(rq[bj][1][j]); }
#pragma unroll
            for (int ai = 0; ai < 2; ++ai)
#pragma unroll
                for (int m = 0; m < 4; ++m) { const int j = row0 + ai * 128 + m * 16; const pg8::f32x4 v0 = acc[ai][bj][m][0], v1 = acc[ai][bj][m][1];
                    u32x4 w; w.x = pk2(v0[0] * r[0], v0[1] * r[1]); w.y = pk2(v0[2] * r[2], v0[3] * r[3]); w.z = pk2(v1[0] * r[4], v1[1] * r[5]); w.w = pk2(v1[2] * r[6], v1[3] * r[7]);
                    *(u32x4*)(Vt + ((size_t)(b * 1024 + j)) * SEQ + s) = w; } }
    }
};
template <bool FIRST> struct EpiMerge {
    static constexpr bool PERM = true, AFTER_DRAIN = false, DUAL = false;
    bf16* Mg; const bf16* G;
    __device__ __forceinline__ void operator()(const pg8::f32x4 (&acc)[2][2][4][2], const pg8::Unit& u, int wr, int wc, int fr, int fq) const {
        const int row0 = u.pm * 256 + wr * 64 + fr, col0 = u.pn * 256 + wc * 32 + 8 * fq;
#pragma unroll
        for (int ai = 0; ai < 2; ++ai) {
            u32x4 gv[4][2], ov[4][2];
#pragma unroll
            for (int m = 0; m < 4; ++m)
#pragma unroll
                for (int bj = 0; bj < 2; ++bj) { const int row = row0 + ai * 128 + m * 16, col = col0 + bj * 128;
                    gv[m][bj] = *(const u32x4*)(G + (size_t)row * PW + col);
                    if (!FIRST) ov[m][bj] = *(const u32x4*)(Mg + (size_t)row * DM + col); }
            asm volatile("" ::: "memory");
#pragma unroll
            for (int m = 0; m < 4; ++m)
#pragma unroll
                for (int bj = 0; bj < 2; ++bj) { const int row = row0 + ai * 128 + m * 16, col = col0 + bj * 128;
                    const u32x4 g = gv[m][bj];
                    const pg8::f32x4 v0 = acc[ai][bj][m][0], v1 = acc[ai][bj][m][1];
                    float o[8] = {v0[0] * bf_lo(g.x), v0[1] * bf_hi(g.x), v0[2] * bf_lo(g.y), v0[3] * bf_hi(g.y), v1[0] * bf_lo(g.z), v1[1] * bf_hi(g.z), v1[2] * bf_lo(g.w), v1[3] * bf_hi(g.w)};
                    if (!FIRST) { const u32x4 old = ov[m][bj];
                        o[0] += bf_lo(old.x); o[1] += bf_hi(old.x); o[2] += bf_lo(old.y); o[3] += bf_hi(old.y); o[4] += bf_lo(old.z); o[5] += bf_hi(old.z); o[6] += bf_lo(old.w); o[7] += bf_hi(old.w); }
                    u32x4 w; w.x = pk2(o[0], o[1]); w.y = pk2(o[2], o[3]); w.z = pk2(o[4], o[5]); w.w = pk2(o[6], o[7]);
                    *(u32x4*)(Mg + (size_t)row * DM + col) = w; }
            asm volatile("" ::: "memory");
        }
    }
};
struct EpiResid {
    static constexpr bool PERM = false, AFTER_DRAIN = false, DUAL = false;
    const float* xin; float* xout; bf16* xb; float* rsum; const float* rsc;
    __device__ __forceinline__ void operator()(const pg8::f32x4 (&acc)[2][2][4][2], const pg8::Unit& u, int wr, int wc, int fr, int fq) const {
        const int row0 = u.pm * 256 + wr * 64 + fr, col0 = u.pn * 256 + wc * 32 + 4 * fq;
#pragma unroll
        for (int ai = 0; ai < 2; ++ai) {
            f32x4 xv[4][2][2];
#pragma unroll
            for (int m = 0; m < 4; ++m)
#pragma unroll
                for (int bj = 0; bj < 2; ++bj)
#pragma unroll
                    for (int n = 0; n < 2; ++n) xv[m][bj][n] = *(const f32x4*)(xin + (size_t)(row0 + ai * 128 + m * 16) * DM + col0 + bj * 128 + n * 16);
            float rr[4];
#pragma unroll
            for (int m = 0; m < 4; ++m) rr[m] = rsc ? rsc[row0 + ai * 128 + m * 16] : 0.f;
            asm volatile("" ::: "memory");
#pragma unroll
            for (int m = 0; m < 4; ++m) { const float r1 = rstd_of(rr[m]); rr[m] = rsc ? r1 * r1 : 1.f; }
#pragma unroll
            for (int m = 0; m < 4; ++m) { const int row = row0 + ai * 128 + m * 16; float ss = 0.f;
#pragma unroll
                for (int bj = 0; bj < 2; ++bj)
#pragma unroll
                    for (int n = 0; n < 2; ++n) { const size_t off = (size_t)row * DM + col0 + bj * 128 + n * 16; f32x4 o;
#pragma unroll
                        for (int j = 0; j < 4; ++j) { o[j] = xv[m][bj][n][j] + acc[ai][bj][m][n][j] * rr[m]; ss += o[j] * o[j]; }
                        *(f32x4*)(xout + off) = o;
                        u32x2 w; w.x = pk2(o[0], o[1]); w.y = pk2(o[2], o[3]); *(u32x2*)(xb + off) = w; }
                ss += __shfl_xor(ss, 16); ss += __shfl_xor(ss, 32);
                if (fq == 0) unsafeAtomicAdd(rsum + row, ss); }
            asm volatile("" ::: "memory");
        }
    }
};
struct EpiResidNorm {
    static constexpr bool PERM = false, AFTER_DRAIN = false, DUAL = false;
    const float* xin; float* out; float* rsum; const float* rsc; const float* gfin; unsigned* cnt;
    __device__ __forceinline__ void operator()(pg8::f32x4 (&acc)[2][2][4][2], const pg8::Unit& u, int wr, int wc, int fr, int fq) const {
        const int row0 = u.pm * 256 + wr * 64 + fr, col0 = u.pn * 256 + wc * 32 + 4 * fq;
#pragma unroll
        for (int ai = 0; ai < 2; ++ai) {
            f32x4 xv[4][2][2];
#pragma unroll
            for (int m = 0; m < 4; ++m)
#pragma unroll
                for (int bj = 0; bj < 2; ++bj)
#pragma unroll
                    for (int n = 0; n < 2; ++n) xv[m][bj][n] = *(const f32x4*)(xin + (size_t)(row0 + ai * 128 + m * 16) * DM + col0 + bj * 128 + n * 16);
            float rr[4];
#pragma unroll
            for (int m = 0; m < 4; ++m) rr[m] = rsc[row0 + ai * 128 + m * 16];
            asm volatile("" ::: "memory");
#pragma unroll
            for (int m = 0; m < 4; ++m) { const float r1 = rstd_of(rr[m]); const float r2 = r1 * r1; float ss = 0.f;
#pragma unroll
                for (int bj = 0; bj < 2; ++bj)
#pragma unroll
                    for (int n = 0; n < 2; ++n) {
#pragma unroll
                        for (int j = 0; j < 4; ++j) { const float o = xv[m][bj][n][j] + acc[ai][bj][m][n][j] * r2; acc[ai][bj][m][n][j] = o; ss += o * o; } }
                ss += __shfl_xor(ss, 16); ss += __shfl_xor(ss, 32);
                if (fq == 0) unsafeAtomicAdd(rsum + row0 + ai * 128 + m * 16, ss); }
        }
        asm volatile("s_waitcnt vmcnt(0)" ::: "memory");
        unsigned* c = cnt + u.pm;
        if ((threadIdx.x & 63) == 0) __hip_atomic_fetch_add(c, 1u, __ATOMIC_RELAXED, __HIP_MEMORY_SCOPE_AGENT);
        { unsigned spins = 0; while (__hip_atomic_load(c, __ATOMIC_RELAXED, __HIP_MEMORY_SCOPE_AGENT) < 32u && ++spins < (1u << 22)) __builtin_amdgcn_s_sleep(4); }
        asm volatile("" ::: "memory");
        f32x4 gq[2][2];
#pragma unroll
        for (int bj = 0; bj < 2; ++bj)
#pragma unroll
            for (int n = 0; n < 2; ++n) gq[bj][n] = *(const f32x4*)(gfin + col0 + bj * 128 + n * 16);
        float rt[8];
#pragma unroll
        for (int i = 0; i < 8; ++i) rt[i] = __hip_atomic_load(rsum + row0 + (i >> 2) * 128 + (i & 3) * 16, __ATOMIC_RELAXED, __HIP_MEMORY_SCOPE_AGENT);
#pragma unroll
        for (int ai = 0; ai < 2; ++ai)
#pragma unroll
            for (int m = 0; m < 4; ++m) { const float r = rstd_of(rt[ai * 4 + m]);
#pragma unroll
                for (int bj = 0; bj < 2; ++bj)
#pragma unroll
                    for (int n = 0; n < 2; ++n) { const f32x4 g = gq[bj][n]; f32x4 o;
#pragma unroll
                        for (int j = 0; j < 4; ++j) o[j] = acc[ai][bj][m][n][j] * r * g[j];
                        *(f32x4*)(out + (size_t)(row0 + ai * 128 + m * 16) * DM + col0 + bj * 128 + n * 16) = o; } }
    }
};
struct EpiUp {
    static constexpr bool PERM = true, AFTER_DRAIN = false, DUAL = false;
    bf16* U; const float* rs;
    __device__ __forceinline__ void operator()(const pg8::f32x4 (&acc)[2][2][4][2], const pg8::Unit& u, int wr, int wc, int fr, int fq) const {
        const int row0 = u.pm * 256 + wr * 64 + fr, col0 = u.pn * 256 + wc * 32 + 8 * fq;
#pragma unroll
        for (int ai = 0; ai < 2; ++ai)
#pragma unroll
            for (int m = 0; m < 4; ++m) { const int row = row0 + ai * 128 + m * 16; bf16* rowp = U + (size_t)row * DFF + col0;
#pragma unroll
                for (int bj = 0; bj < 2; ++bj) { pg8::f32x4 v0 = acc[ai][bj][m][0], v1 = acc[ai][bj][m][1];
#pragma unroll
                    for (int j = 0; j < 4; ++j) { const float a = fmaxf(v0[j], 0.f), b = fmaxf(v1[j], 0.f); v0[j] = a * a; v1[j] = b * b; }
                    u32x4 w; w.x = pk2(v0[0], v0[1]); w.y = pk2(v0[2], v0[3]); w.z = pk2(v1[0], v1[1]); w.w = pk2(v1[2], v1[3]);
                    *(u32x4*)(rowp + bj * 128) = w; } }
    }
};

struct EpiMergeDual {
    static constexpr bool PERM = true, AFTER_DRAIN = false, DUAL = true;
    bf16* Mg; const bf16* P;
    __device__ __forceinline__ void operator()(pg8::f32x4 (&acc)[2][2][4][2], const pg8::Unit& u, int wr, int wc, int fr, int fq) const {
        const int row0 = u.pm * 256 + wr * 64 + fr, col0 = u.pn * 256 + wc * 32 + 8 * fq;
        if (u.half == 0) {
#pragma unroll
            for (int ai = 0; ai < 2; ++ai) {
                u32x4 ga[4][2], gb[4][2];
#pragma unroll
                for (int m = 0; m < 4; ++m)
#pragma unroll
                    for (int bj = 0; bj < 2; ++bj) { const bf16* gp = P + (size_t)(row0 + ai * 128 + m * 16) * PW + col0 + bj * 128;
                        ga[m][bj] = *(const u32x4*)(gp + 2048); gb[m][bj] = *(const u32x4*)(gp + 3072); }
#pragma unroll
                for (int m = 0; m < 4; ++m)
#pragma unroll
                    for (int bj = 0; bj < 2; ++bj) { const u32x4 a = ga[m][bj], b = gb[m][bj];
                        const float ra[8] = {bf_lo(a.x), bf_hi(a.x), bf_lo(a.y), bf_hi(a.y), bf_lo(a.z), bf_hi(a.z), bf_lo(a.w), bf_hi(a.w)};
                        const float rb[8] = {bf_lo(b.x), bf_hi(b.x), bf_lo(b.y), bf_hi(b.y), bf_lo(b.z), bf_hi(b.z), bf_lo(b.w), bf_hi(b.w)};
#pragma unroll
                        for (int j = 0; j < 4; ++j) { acc[ai][bj][m][0][j] *= ra[j] * __builtin_amdgcn_rcpf(fmaxf(rb[j], 1e-20f)); acc[ai][bj][m][1][j] *= ra[4 + j] * __builtin_amdgcn_rcpf(fmaxf(rb[4 + j], 1e-20f)); } }
            }
        } else {
#pragma unroll
            for (int ai = 0; ai < 2; ++ai) {
                u32x4 gb[4][2];
#pragma unroll
                for (int m = 0; m < 4; ++m)
#pragma unroll
                    for (int bj = 0; bj < 2; ++bj) gb[m][bj] = *(const u32x4*)(P + (size_t)(row0 + ai * 128 + m * 16) * PW + col0 + bj * 128 + 3072);
                asm volatile("" ::: "memory");
#pragma unroll
                for (int m = 0; m < 4; ++m)
#pragma unroll
                    for (int bj = 0; bj < 2; ++bj) { const u32x4 b = gb[m][bj];
                        const float rb[8] = {bf_lo(b.x), bf_hi(b.x), bf_lo(b.y), bf_hi(b.y), bf_lo(b.z), bf_hi(b.z), bf_lo(b.w), bf_hi(b.w)};
                        float o[8];
#pragma unroll
                        for (int j = 0; j < 4; ++j) { o[j] = acc[ai][bj][m][0][j] * fmaxf(rb[j], 1e-20f); o[4 + j] = acc[ai][bj][m][1][j] * fmaxf(rb[4 + j], 1e-20f); }
                        u32x4 w; w.x = pk2(o[0], o[1]); w.y = pk2(o[2], o[3]); w.z = pk2(o[4], o[5]); w.w = pk2(o[6], o[7]);
                        *(u32x4*)(Mg + (size_t)(row0 + ai * 128 + m * 16) * DM + col0 + bj * 128) = w; }
                asm volatile("" ::: "memory");
            }
        }
    }
};
#ifdef PROBE_KLOOP
struct EpiUpProbe {
    static constexpr bool PERM = true, AFTER_DRAIN = false, DUAL = true;
    bf16* U;
    __device__ __forceinline__ void operator()(pg8::f32x4 (&acc)[2][2][4][2], const pg8::Unit& u, int wr, int wc, int fr, int fq) const {
        if (u.half == 0) return;
        const int row0 = u.pm * 256 + wr * 64 + fr, col0 = u.pn * 256 + wc * 32 + 8 * fq;
#pragma unroll
        for (int ai = 0; ai < 2; ++ai)
#pragma unroll
            for (int m = 0; m < 4; ++m) { const int row = row0 + ai * 128 + m * 16; bf16* rowp = U + (size_t)row * DFF + col0;
#pragma unroll
                for (int bj = 0; bj < 2; ++bj) { pg8::f32x4 v0 = acc[ai][bj][m][0] * 0.5f, v1 = acc[ai][bj][m][1] * 0.5f;
#pragma unroll
                    for (int j = 0; j < 4; ++j) { const float a = fmaxf(v0[j], 0.f), b = fmaxf(v1[j], 0.f); v0[j] = a * a; v1[j] = b * b; }
                    u32x4 w; w.x = pk2(v0[0], v0[1]); w.y = pk2(v0[2], v0[3]); w.z = pk2(v1[0], v1[1]); w.w = pk2(v1[2], v1[3]);
                    *(u32x4*)(rowp + bj * 128) = w; } }
    }
};
#endif
struct DualOrder {
    pg8::StaticOrder b;
    __device__ void init(int M, int N, int G_, int c_) { b.init(M, N, G_, c_); }
    __device__ bool next(int i, pg8::Unit& u) const { if (!b.next(i >> 1, u)) return false; u.half = i & 1; return true; }
    __device__ __forceinline__ void a_ready(const pg8::Unit&) const {}
    __device__ __forceinline__ void done(const pg8::Unit&) const {}
};

constexpr int KPITCH = 144;
constexpr int AB_K = 0, AB_V = 64 * KPITCH, AB_C = 2 * 64 * KPITCH, AB_SZ = AB_C + 256, AT_TAB = 2 * AB_SZ;
constexpr float AT_SKIP = 40.f, AT_THR = 8.f;
constexpr int AT_OST = AT_TAB + 1040 + 64, AT_OPITCH = 144;
constexpr int AT_FLAGS = AT_TAB + 1040;
__device__ __forceinline__ float max3f_(float a, float b, float c) { float r; asm("v_max3_f32 %0, %1, %2, %3" : "=v"(r) : "v"(a), "v"(b), "v"(c)); return r; }
__device__ __forceinline__ int crow(int r, int hi) { return (r & 3) + 8 * (r >> 2) + 4 * hi; }

template <bool FOX>
__device__ __forceinline__ void at_qk(f32x16& S0, f32x16& S1, const bf16x8 (&qr)[4], LAS unsigned char* kb, LAS float* tab, int t, int cq, int w, int r32, int hi) {
    if (FOX) {
#pragma unroll
        for (int g = 0; g < 4; ++g) { const f32x4 c0 = *(const LAS f32x4*)(kb + AB_C + (8 * g + 4 * hi) * 4), c1 = *(const LAS f32x4*)(kb + AB_C + (32 + 8 * g + 4 * hi) * 4);
#pragma unroll
            for (int j = 0; j < 4; ++j) { S0[4 * g + j] = c0[j]; S1[4 * g + j] = c1[j]; } }
    } else if (t >= cq - 2) {
        const int dbase = 64 * (cq - t) + (w & 1) * 32 + r32; const LAS float* pbase = tab + (dbase + 5 - 4 * hi);
#pragma unroll
        for (int r = 0; r < 16; ++r) { S0[r] = pbase[59 - ((r & 3) + 8 * (r >> 2))]; S1[r] = pbase[27 - ((r & 3) + 8 * (r >> 2))]; }
    } else { const float bf = tab[255];
#pragma unroll
        for (int r = 0; r < 16; ++r) { S0[r] = bf; S1[r] = bf; } }
#pragma unroll
    for (int ds = 0; ds < 4; ++ds) {
        const bf16x8 a0 = *(const LAS bf16x8*)(kb + AB_K + r32 * KPITCH + ds * 32 + hi * 16);
        const bf16x8 a1 = *(const LAS bf16x8*)(kb + AB_K + (32 + r32) * KPITCH + ds * 32 + hi * 16);
        S0 = __builtin_amdgcn_mfma_f32_32x32x16_bf16(a0, qr[ds], S0, 0, 0, 0);
        S1 = __builtin_amdgcn_mfma_f32_32x32x16_bf16(a1, qr[ds], S1, 0, 0, 0);
    }
#ifdef PROBE_MFMA
    { f32x16 D0 = {}, D1 = {};
#pragma unroll
      for (int ds = 0; ds < 4; ++ds) {
        const bf16x8 a0 = *(const LAS bf16x8*)(kb + AB_K + r32 * KPITCH + ds * 32 + hi * 16);
        const bf16x8 a1 = *(const LAS bf16x8*)(kb + AB_K + (32 + r32) * KPITCH + ds * 32 + hi * 16);
        D0 = __builtin_amdgcn_mfma_f32_32x32x16_bf16(a0, qr[ds], D0, 0, 0, 0);
        D1 = __builtin_amdgcn_mfma_f32_32x32x16_bf16(a1, qr[ds], D1, 0, 0, 0); }
      asm volatile("" :: "v"(D0), "v"(D1)); }
#endif
    if (FOX && t == cq) { const int qrel = (w & 1) * 32 + r32;
#pragma unroll
        for (int r = 0; r < 16; ++r) { const int kv = crow(r, hi); if (kv > qrel) S0[r] = -1e30f; if (kv + 32 > qrel) S1[r] = -1e30f; } }
}
__device__ __forceinline__ void at_pv(f32x16& o0, f32x16& o1, const u32x4 (&pw)[4], LAS unsigned char* vb, int r32, int hi) {
#pragma unroll
    for (int ks = 0; ks < 4; ++ks) {
        const bf16x8 v0 = *(const LAS bf16x8*)(vb + AB_V + r32 * KPITCH + (16 * ks + 8 * hi) * 2);
        const bf16x8 v1 = *(const LAS bf16x8*)(vb + AB_V + (32 + r32) * KPITCH + (16 * ks + 8 * hi) * 2);
        o0 = __builtin_amdgcn_mfma_f32_32x32x16_bf16(v0, __builtin_bit_cast(bf16x8, pw[ks]), o0, 0, 0, 0);
        o1 = __builtin_amdgcn_mfma_f32_32x32x16_bf16(v1, __builtin_bit_cast(bf16x8, pw[ks]), o1, 0, 0, 0);
    }
}
__device__ __forceinline__ bool at_softmax(f32x16& S0, f32x16& S1, float& mref, float& lrun, float& alpha_pend, bool& resc_pend, u32x4 (&pw)[4]) {
    float mx = fmaxf(S0[0], S1[0]), mx2 = fmaxf(S0[1], S1[1]);
#pragma unroll
    for (int r = 2; r < 16; r += 2) { mx = max3f_(mx, S0[r], S1[r]); mx2 = max3f_(mx2, S0[r + 1], S1[r + 1]); }
    mx = fmaxf(mx, mx2);
    mx = fmaxf(mx, __shfl_xor(mx, 32));
    if (__all(mx < mref - AT_SKIP)) return true;
    if (__any(mx > mref + AT_THR)) { const float mnew = fmaxf(mref, mx), a = __builtin_amdgcn_exp2f(mref - mnew);
        lrun *= a; alpha_pend = resc_pend ? alpha_pend * a : a; resc_pend = true; mref = mnew; }
    float ls = 0.f;
#pragma unroll
    for (int r = 0; r < 16; ++r) { S0[r] = __builtin_amdgcn_exp2f(S0[r] - mref); S1[r] = __builtin_amdgcn_exp2f(S1[r] - mref); ls += S0[r] + S1[r]; }
    lrun += ls;
#ifdef PROBE_VALU
    { float dm = 0.f;
#pragma unroll
      for (int r = 0; r < 16; ++r) { dm += __builtin_amdgcn_exp2f(S0[r] - 3.f) + __builtin_amdgcn_exp2f(S1[r] - 3.f); dm = fmaxf(dm, S0[r] * S1[r]); }
      asm volatile("" :: "v"(dm)); }
#endif
    pw[0].x = pk2(S0[0], S0[1]); pw[0].y = pk2(S0[2], S0[3]); pw[0].z = pk2(S0[4], S0[5]); pw[0].w = pk2(S0[6], S0[7]);
    pw[1].x = pk2(S0[8], S0[9]); pw[1].y = pk2(S0[10], S0[11]); pw[1].z = pk2(S0[12], S0[13]); pw[1].w = pk2(S0[14], S0[15]);
    pw[2].x = pk2(S1[0], S1[1]); pw[2].y = pk2(S1[2], S1[3]); pw[2].z = pk2(S1[4], S1[5]); pw[2].w = pk2(S1[6], S1[7]);
    pw[3].x = pk2(S1[8], S1[9]); pw[3].y = pk2(S1[10], S1[11]); pw[3].z = pk2(S1[12], S1[13]); pw[3].w = pk2(S1[14], S1[15]);
    return false;
}

struct AtState { float mref, lrun, alpha_pend, smax; bool resc_pend, pv_pend, wave_done, hvx, hvy; };
template <bool FOX, bool GRPB>
__device__ __forceinline__ bool at_interval(int k, int NT, int t1, int cq, int w, int r32, int hi, int lane, int tid, int srow, int sch,
                                            f32x16& X0, f32x16& X1, f32x16& Y0, f32x16& Y1, f32x16& o0, f32x16& o1, u32x4 (&pw)[4], AtState& st, bool& hvX, bool& hvY,
                                            u32x4& ldk, u32x4& ldv, float& ldc, const u32x4& stk, const u32x4& stv, const float& stc,
                                            const bf16x8 (&qr)[4], LAS unsigned char* lds, LAS float* tab, const bf16* kg, const bf16* vg, const float* cgp) {
    LAS unsigned char* rb = lds + ((k + 1) & 1) * AB_SZ;
    LAS unsigned char* wb = lds + (k & 1) * AB_SZ;
    const bool has2 = k + 2 < NT;
    if (k + 3 < NT) { const int t = t1 - (k + 3); ldk = *(const u32x4*)(kg + (size_t)t * 64 * PW); if (FOX) ldc = cgp[(size_t)t * 64]; }
    if (k + 1 < NT) { const int t = t1 - (k + 1); ldv = *(const u32x4*)(vg + (size_t)t * 64); }
    const int tn = t1 - (k + 1);
    const bool act_n = (k + 1 < NT) && (FOX ? (tn <= cq) : (tn >= cq - 8 && tn <= cq)) && !st.wave_done;
    if (!GRPB) {
        if (act_n) { at_qk<FOX>(Y0, Y1, qr, rb, tab, tn, cq, w, r32, hi); hvY = true; }
        if (st.resc_pend) {
#pragma unroll
            for (int r = 0; r < 16; ++r) { o0[r] *= st.alpha_pend; o1[r] *= st.alpha_pend; }
            st.resc_pend = false; }
        if (st.pv_pend) at_pv(o0, o1, pw, rb, r32, hi);
        st.pv_pend = false;
        if (hvX) { st.pv_pend = !at_softmax(X0, X1, st.mref, st.lrun, st.alpha_pend, st.resc_pend, pw); hvX = false; }
    } else {
        if (hvY) { st.pv_pend = !at_softmax(Y0, Y1, st.mref, st.lrun, st.alpha_pend, st.resc_pend, pw); hvY = false; }
        if (st.resc_pend) {
#pragma unroll
            for (int r = 0; r < 16; ++r) { o0[r] *= st.alpha_pend; o1[r] *= st.alpha_pend; }
            st.resc_pend = false; }
        if (st.pv_pend) at_pv(o0, o1, pw, rb, r32, hi);
        st.pv_pend = false;
        if (act_n) { at_qk<FOX>(Y0, Y1, qr, rb, tab, tn, cq, w, r32, hi); hvY = true; }
    }
    LAS unsigned* flags = (LAS unsigned*)(lds + AT_FLAGS);
    if (FOX) {
        if (k + 1 < NT) { const float cb = *(const LAS float*)(rb + AB_C + 63 * 4); if (__all(st.smax + cb < st.mref - AT_SKIP)) st.wave_done = true; }
        if (lane == 0) flags[(k & 1) * 8 + w] = st.wave_done ? 1u : 0u; }
    if (has2) { *(LAS u32x4*)(wb + AB_K + srow * KPITCH + sch * 16) = stk; if (FOX && tid < 64) *(LAS float*)(wb + AB_C + tid * 4) = -stc; }
    { const int pa = 16 * (sch >> 1) + 4 * (sch & 1); u32x2 va; va.x = stv.x; va.y = stv.y; u32x2 vb; vb.x = stv.z; vb.y = stv.w;
      *(LAS u32x2*)(wb + AB_V + srow * KPITCH + pa * 2) = va; *(LAS u32x2*)(wb + AB_V + srow * KPITCH + (pa + 8) * 2) = vb; }
#ifdef PROBE_BAR
    asm volatile("s_waitcnt lgkmcnt(0)\n\ts_barrier" ::: "memory");
#endif
    asm volatile("s_waitcnt lgkmcnt(0)\n\ts_barrier" ::: "memory");
    if (k + 1 >= NT) return true;
    if (FOX) { const u32x4 f0 = *(const LAS u32x4*)(flags + (k & 1) * 8), f1 = *(const LAS u32x4*)(flags + (k & 1) * 8 + 4);
        const unsigned all = f0.x & f0.y & f0.z & f0.w & f1.x & f1.y & f1.z & f1.w;
        if (__builtin_amdgcn_readfirstlane(all) != 0u) return true; }
    return false;
}
template <bool FOX, bool GRPB>
__device__ __forceinline__ void at_walk(int NT, int t1, int cq, int w, int r32, int hi, int lane, int tid, int srow, int sch, f32x16& o0, f32x16& o1, AtState& st,
                                        const bf16x8 (&qr)[4], LAS unsigned char* lds, LAS float* tab, const bf16* kg, const bf16* vg, const float* cgp) {
    f32x16 e0 = {}, e1 = {}, d0 = {}, d1 = {}; u32x4 pw[4]; bool hve = false, hvd = false;
    { const int t = t1; if (FOX ? (t <= cq) : (t >= cq - 8 && t <= cq)) { at_qk<FOX>(e0, e1, qr, lds, tab, t, cq, w, r32, hi); hve = true; } }
    __syncthreads();
    u32x4 ek = {}, ev = {}, dk = {}, dv = {}; float ec = 0.f, dc = 0.f;
    if (2 < NT) { const int t = t1 - 2; dk = *(const u32x4*)(kg + (size_t)t * 64 * PW); if (FOX) dc = cgp[(size_t)t * 64]; }
    dv = *(const u32x4*)(vg + (size_t)t1 * 64);
    int k = 0;
    for (;;) {
        if (at_interval<FOX, GRPB>(k, NT, t1, cq, w, r32, hi, lane, tid, srow, sch, e0, e1, d0, d1, o0, o1, pw, st, hve, hvd, ek, ev, ec, dk, dv, dc, qr, lds, tab, kg, vg, cgp)) break;
        ++k;
        if (at_interval<FOX, GRPB>(k, NT, t1, cq, w, r32, hi, lane, tid, srow, sch, d0, d1, e0, e1, o0, o1, pw, st, hvd, hve, dk, dv, dc, ek, ev, ec, qr, lds, tab, kg, vg, cgp)) break;
        ++k;
    }
    asm volatile("s_waitcnt vmcnt(0)" ::: "memory");
    if (GRPB) { if (k & 1) { if (hvd) st.pv_pend = !at_softmax(d0, d1, st.mref, st.lrun, st.alpha_pend, st.resc_pend, pw); }
                else       { if (hve) st.pv_pend = !at_softmax(e0, e1, st.mref, st.lrun, st.alpha_pend, st.resc_pend, pw); } }
    if (st.resc_pend) {
#pragma unroll
        for (int r = 0; r < 16; ++r) { o0[r] *= st.alpha_pend; o1[r] *= st.alpha_pend; } }
    if (st.pv_pend) at_pv(o0, o1, pw, lds + (k & 1) * AB_SZ, r32, hi);
}

template <bool FOX>
__device__ __forceinline__ void attn_unit(LAS unsigned char* lds, int b, int h, int qb, const bf16* __restrict__ P, const bf16* __restrict__ Vt,
                                          const float* __restrict__ c2, const float* __restrict__ relb, bf16* __restrict__ O, float kn) {
    int tid_l = threadIdx.x; asm volatile("" : "+v"(tid_l));
    const int tid = tid_l, lane = tid & 63, r32 = lane & 31, hi = lane >> 5;
    const int w = __builtin_amdgcn_readfirstlane(tid >> 6);
    constexpr int QOFF = FOX ? 0 : 1024, KOFF = FOX ? 512 : 1536, VOFF = FOX ? 0 : 512;
    const size_t tokq = (size_t)b * SEQ + qb * 256 + w * 32 + r32;
    bf16x8 qr[4];
    { const bf16* qp = P + tokq * PW + QOFF + h * 64 + hi * 8;
#pragma unroll
      for (int ds = 0; ds < 4; ++ds) qr[ds] = *(const bf16x8*)(qp + ds * 16); }
    AtState st; st.mref = -1e30f; st.lrun = 0.f; st.alpha_pend = 1.f; st.smax = 0.f; st.resc_pend = false; st.pv_pend = false; st.wave_done = false; st.hvx = false; st.hvy = false;
    if (FOX) { float q2 = 0.f;
#pragma unroll
        for (int ds = 0; ds < 4; ++ds) { const u32x4 qu = __builtin_bit_cast(u32x4, qr[ds]);
            q2 += bf_lo(qu.x) * bf_lo(qu.x) + bf_hi(qu.x) * bf_hi(qu.x) + bf_lo(qu.y) * bf_lo(qu.y) + bf_hi(qu.y) * bf_hi(qu.y)
                + bf_lo(qu.z) * bf_lo(qu.z) + bf_hi(qu.z) * bf_hi(qu.z) + bf_lo(qu.w) * bf_lo(qu.w) + bf_hi(qu.w) * bf_hi(qu.w); }
        q2 += __shfl_xor(q2, 32); st.smax = sqrtf(q2) * kn * 1.01f + 0.01f; }
    const int t1 = 4 * qb + 3, t0 = FOX ? 0 : (4 * qb - 8 > 0 ? 4 * qb - 8 : 0), NT = t1 - t0 + 1;
    const int cq = 4 * qb + (w >> 1);
    const int srow = tid >> 3, sch = tid & 7;
    const bf16* kg = P + ((size_t)b * SEQ + srow) * PW + KOFF + h * 64 + sch * 8;
    const bf16* vg = Vt + ((size_t)(b * 1024 + VOFF + h * 64 + srow)) * SEQ + sch * 8;
    const float* cgp = c2 + (size_t)(b * 8 + h) * SEQ + (tid & 63);
    LAS float* tab = (LAS float*)(lds + AT_TAB);
    if (!FOX) { if (tid < 256) tab[tid] = relb[tid + 64 < 256 ? tid + 64 : 256] * LOG2E; }
#pragma unroll
    for (int i = 0; i < 2; ++i) if (i < NT) { const int t = t1 - i; LAS unsigned char* bb = lds + i * AB_SZ;
        const u32x4 kreg = *(const u32x4*)(kg + (size_t)t * 64 * PW); *(LAS u32x4*)(bb + AB_K + srow * KPITCH + sch * 16) = kreg;
        if (FOX && tid < 64) *(LAS float*)(bb + AB_C + tid * 4) = -cgp[(size_t)t * 64]; }
    __syncthreads();
    f32x16 o0 = {}, o1 = {};
    if (w >= 4) __builtin_amdgcn_s_setprio(1);
    if (w < 4) at_walk<FOX, false>(NT, t1, cq, w, r32, hi, lane, tid, srow, sch, o0, o1, st, qr, lds, tab, kg, vg, cgp);
    else       at_walk<FOX, true >(NT, t1, cq, w, r32, hi, lane, tid, srow, sch, o0, o1, st, qr, lds, tab, kg, vg, cgp);
    __builtin_amdgcn_s_setprio(0);
    float lrun = st.lrun;
    lrun += __shfl_xor(lrun, 32);
    const float inv = __builtin_amdgcn_rcpf(lrun);
    { LAS unsigned char* ost = lds + AT_OST + w * (32 * AT_OPITCH);
#pragma unroll
      for (int g = 0; g < 4; ++g) {
        u32x2 a; a.x = pk2(o0[4 * g] * inv, o0[4 * g + 1] * inv); a.y = pk2(o0[4 * g + 2] * inv, o0[4 * g + 3] * inv);
        u32x2 c; c.x = pk2(o1[4 * g] * inv, o1[4 * g + 1] * inv); c.y = pk2(o1[4 * g + 2] * inv, o1[4 * g + 3] * inv);
        *(LAS u32x2*)(ost + r32 * AT_OPITCH + (8 * g + 4 * hi) * 2) = a; *(LAS u32x2*)(ost + r32 * AT_OPITCH + (32 + 8 * g + 4 * hi) * 2) = c; }
      asm volatile("s_waitcnt lgkmcnt(0)" ::: "memory");
      bf16* ob = O + ((size_t)b * SEQ + qb * 256 + w * 32) * 512 + h * 64;
#pragma unroll
      for (int i = 0; i < 4; ++i) { const int row = i * 8 + (lane >> 3), ch = lane & 7;
        const u32x4 v = *(const LAS u32x4*)(ost + row * AT_OPITCH + ch * 16); *(u32x4*)(ob + (size_t)row * 512 + ch * 8) = v; } }
    __syncthreads();
}


__device__ __forceinline__ float wave_sum(float v) {
#pragma unroll
    for (int o = 1; o < 64; o <<= 1) v += __shfl_xor(v, o);
    return v;
}
__device__ __forceinline__ void transpose_item(const float* __restrict__ W, int ldw, const float* __restrict__ gk, bf16* __restrict__ WT, int ldt, int dest_row0, int src_col0, int k0, LAS float* scr, int lane) {
#pragma unroll
    for (int i = 0; i < 32; ++i) { const int kk = 2 * i + (lane >> 5); float v = W[(size_t)(k0 + kk) * ldw + src_col0 + (lane & 31)]; if (gk) v *= gk[k0 + kk]; scr[kk * 33 + (lane & 31)] = v; }
    asm volatile("s_waitcnt lgkmcnt(0)" ::: "memory");
    const int c = lane & 7;
#pragma unroll
    for (int j = 0; j < 4; ++j) { const int n = (lane >> 3) + 8 * j; const LAS float* s = scr + (8 * c) * 33 + n;
        u32x4 o; o.x = pk2(s[0 * 33], s[1 * 33]); o.y = pk2(s[2 * 33], s[3 * 33]); o.z = pk2(s[4 * 33], s[5 * 33]); o.w = pk2(s[6 * 33], s[7 * 33]);
        *(u32x4*)(WT + (size_t)(dest_row0 + n) * ldt + k0 + 8 * c) = o; }
    asm volatile("s_waitcnt lgkmcnt(0)" ::: "memory");
}
__device__ __forceinline__ void ti_load(const float* __restrict__ W, int ldw, int src_col0, int k0, int lane, float (&v)[32]) {
#pragma unroll
    for (int i = 0; i < 32; ++i) { const int kk = 2 * i + (lane >> 5); v[i] = W[(size_t)(k0 + kk) * ldw + src_col0 + (lane & 31)]; }
}
__device__ __forceinline__ void ti_finish(const float (&v)[32], const float* __restrict__ gk, bf16* __restrict__ WT, int ldt, int dest_row0, int k0, LAS float* scr, int lane) {
    const int c = lane & 7;
    f32x4 g0 = {1.f, 1.f, 1.f, 1.f}, g1 = {1.f, 1.f, 1.f, 1.f};
    if (gk) { g0 = *(const f32x4*)(gk + k0 + 8 * c); g1 = *(const f32x4*)(gk + k0 + 8 * c + 4); }
#pragma unroll
    for (int i = 0; i < 32; ++i) { const int kk = 2 * i + (lane >> 5); scr[kk * 33 + (lane & 31)] = v[i]; }
    asm volatile("s_waitcnt lgkmcnt(0)" ::: "memory");
#pragma unroll
    for (int j = 0; j < 4; ++j) { const int n = (lane >> 3) + 8 * j; const LAS float* s = scr + (8 * c) * 33 + n;
        u32x4 o; o.x = pk2(s[0 * 33] * g0.x, s[1 * 33] * g0.y); o.y = pk2(s[2 * 33] * g0.z, s[3 * 33] * g0.w); o.z = pk2(s[4 * 33] * g1.x, s[5 * 33] * g1.y); o.w = pk2(s[6 * 33] * g1.z, s[7 * 33] * g1.w);
        *(u32x4*)(WT + (size_t)(dest_row0 + n) * ldt + k0 + 8 * c) = o; }
    asm volatile("s_waitcnt lgkmcnt(0)" ::: "memory");
}
__device__ __forceinline__ int win_src_col(int d) {
    if (d < 1024) return d;
    if (d < 1536) return 1544 + (d - 1024);
    if (d < 2048) return 2056 + (d - 1536);
    if (d < 4096) return 3080 + (d - 2048);
    if (d < 4608) return 1024 + (d - 4096);
    return 2568 + (d - 4608);
}

#define XB_TMO      128
#define XB_XCNT(j)  (256  + 64 * (j))
#define XB_XSUB(j)  (1280 + 64 * (j))
#define XB_XGEN(j)  (2304 + 64 * (j))
#define XB_TOP      3328
#define XB_TOPGEN   3392
#define XCD_BAR_WORDS 3456
#define XB_SPIN_CAP (1u << 18)

__device__ __forceinline__ unsigned xb_ld(unsigned* p)              { return __hip_atomic_load(p, __ATOMIC_RELAXED, __HIP_MEMORY_SCOPE_AGENT); }
__device__ __forceinline__ unsigned xb_add(unsigned* p, unsigned v) { return __hip_atomic_fetch_add(p, v, __ATOMIC_RELAXED, __HIP_MEMORY_SCOPE_AGENT); }
__device__ __forceinline__ unsigned xb_xcc_id() { return (unsigned)__builtin_amdgcn_s_getreg((3 << 11) | 20) & 0xFu; }
#define XB_SPIN(cond, bar) do { unsigned _sp = 0; while (cond) { __builtin_amdgcn_s_sleep(1); \
    if ((++_sp & 255u) == 0u) { if (xb_ld(&(bar)[XB_TMO])) break; if (_sp > XB_SPIN_CAP) { atomicAdd(&(bar)[XB_TMO], 1u); break; } } } } while (0)

struct XcdBarrier {
    unsigned* bar; unsigned x;
    volatile LAS unsigned* st;
};

__device__ __forceinline__ XcdBarrier xcd_barrier_post(unsigned* bar, volatile LAS unsigned* st) {
    XcdBarrier b; b.bar = bar; b.x = xb_xcc_id(); b.st = st;
    if (threadIdx.x == 0) (void)xb_add(&bar[XB_XCNT(b.x)], 1u);
    return b;
}
__device__ __forceinline__ void xcd_barrier_complete(unsigned* bar, unsigned x, unsigned& nloc, unsigned& nx) {
    const unsigned G = gridDim.x * gridDim.y * gridDim.z;
    unsigned sum, cnt, mine, sp = 0u;
    for (;;) {
        sum = 0u; cnt = 0u; mine = 0u;
#pragma unroll
        for (unsigned j = 0; j < 16; ++j) { const unsigned c = xb_ld(&bar[XB_XCNT(j)]); sum += c; cnt += (c > 0u) ? 1u : 0u; mine = (j == x) ? c : mine; }
        if (sum == G) break;
        __builtin_amdgcn_s_sleep(1);
        if ((++sp & 255u) == 0u) { if (xb_ld(&bar[XB_TMO])) break; if (sp > XB_SPIN_CAP) { atomicAdd(&bar[XB_TMO], 1u); break; } }
    }
    nloc = mine > 0u ? mine : 1u; nx = cnt > 0u ? cnt : 1u;
}

__device__ __forceinline__ void xcd_barrier(const XcdBarrier& b) {
    asm volatile("s_waitcnt vmcnt(0)" ::: "memory");
    __syncthreads();
    if (threadIdx.x == 0) {
        unsigned* bar = b.bar;
        __builtin_amdgcn_s_waitcnt(0);
        unsigned nloc = b.st[0], nx = b.st[1];
        if (nloc == 0u) { xcd_barrier_complete(bar, b.x, nloc, nx); b.st[0] = nloc; b.st[1] = nx; }
        const unsigned old = xb_add(&bar[XB_XSUB(b.x)], 1u);
        const unsigned gen = old / nloc;
        if (old + 1u == (gen + 1u) * nloc) {
            __builtin_amdgcn_fence(__ATOMIC_RELEASE, "agent");
            asm volatile("s_waitcnt vmcnt(0)" ::: "memory");
            const unsigned og = xb_add(&bar[XB_TOP], 1u);
            const unsigned tg = og / nx;
            if (og + 1u == (tg + 1u) * nx) xb_add(&bar[XB_TOPGEN], 1u);
            else XB_SPIN(xb_ld(&bar[XB_TOPGEN]) == tg, bar);
            __builtin_amdgcn_fence(__ATOMIC_ACQUIRE, "agent");
            xb_add(&bar[XB_XGEN(b.x)], 1u);
            asm volatile("s_waitcnt vmcnt(0)" ::: "memory");
        } else {
            XB_SPIN(xb_ld(&bar[XB_XGEN(b.x)]) == gen, bar);
            __builtin_amdgcn_fence(__ATOMIC_ACQUIRE, "agent");
            asm volatile("s_waitcnt vmcnt(0)" ::: "memory");
        }
    }
    __syncthreads();
}

constexpr size_t WS_MISC = 800 * 1024;
constexpr size_t WS_BAR = 768 * 1024;
#ifndef PHMASK
#define PHMASK 0xffff
#endif
struct Params { const float* in[12]; float* out; unsigned char* ws; int ph_lo, ph_hi; };

__global__ void __launch_bounds__(512, 2) mega_fwd(Params p) {
    extern __shared__ __attribute__((aligned(16))) unsigned char lds_raw[];
    LAS unsigned char* lds = (LAS unsigned char*)lds_raw;
    cg::grid_group grid = cg::this_grid();
    volatile LAS unsigned* bar_st = (volatile LAS unsigned*)(lds + 131072);
    if (threadIdx.x == 0) { bar_st[0] = 0u; bar_st[1] = 0u; }
    __syncthreads();
    (void)xcd_barrier_post((unsigned*)(p.ws + WS_BAR), bar_st);
    if (p.ph_hi > 1000) grid.sync();
    for (int pc = p.ph_lo; pc < p.ph_hi; ++pc) {
        int ph = pc;
#ifdef PROBE_K
        if (pc >= 1 && pc <= 16) { const int l_ = (pc - 1) / 8, j_ = (pc - 1) % 8; ph = 1 + 7 * l_ + (j_ <= PROBE_K ? j_ : j_ - 1); } else if (pc == 17) ph = 15;
#endif
#ifdef PROBE_SYNCS
        if (pc == 2) { for (int i_ = 0; i_ < PROBE_SYNCS; ++i_) { XcdBarrier xb_; xb_.bar = (unsigned*)(pp->ws + WS_BAR); xb_.x = xb_xcc_id(); xb_.st = bar_st; xcd_barrier(xb_); } }
#endif
        int G = gridDim.x, bx = blockIdx.x; asm volatile("" : "+s"(G), "+s"(bx));
#define PH_BEGIN int tid = threadIdx.x; asm volatile("" : "+v"(tid)); const int lane = tid & 63, wave = __builtin_amdgcn_readfirstlane(tid >> 6); const int gw = bx * 8 + wave, NGW = G * 8; (void)lane; (void)gw; (void)NGW;
        typedef const __attribute__((address_space(4))) Params* kparams_t;
        kparams_t pp = (kparams_t)__builtin_amdgcn_kernarg_segment_ptr(); asm volatile("" : "+s"(pp));
        unsigned char* ws = pp->ws;
#define x_in (pp->in[0])
#define norm1 (pp->in[1])
#define w_in (pp->in[2])
#define fbias (pp->in[3])
#define relb (pp->in[4])
#define w_a (pp->in[5])
#define w_b (pp->in[6])
#define w_out (pp->in[7])
#define norm2 (pp->in[8])
#define w_up (pp->in[9])
#define w_dn (pp->in[10])
#define fnorm (pp->in[11])
#define X (pp->out)
        float* RS = (float*)(ws + WS_RS); float* WF = (float*)(ws + WS_WF); float* LOGF = (float*)(ws + WS_LOGF); float* C2B = (float*)(ws + WS_C2);
        bf16* XB = (bf16*)(ws + WS_XB); bf16* OA = XB; bf16* OB = XB + (size_t)MTOK * 512;
        bf16* VT = (bf16*)(ws + WS_VT); bf16* MG = VT; bf16* PB = (bf16*)(ws + WS_P); bf16* UB = PB;
        if ((PHMASK & 1) && ph == 0) { PH_BEGIN
            LAS float* scr = (LAS float*)(lds + wave * 16384);
            constexpr int I_IN = 16 * 160, I_A = 8 * 32, I_O = 16 * 32, I_UP = 16 * 128, I_DN = 64 * 32, NIT = I_IN + 2 * I_A + I_O + I_UP + I_DN;
#define TI_DEC(IT, W_, ldw_, gk_, WT_, ldt_, dr_, sc_, k0_) do { const int l_ = (IT) / NIT; int r_ = (IT) % NIT; unsigned char* wl_ = ws + WS_W + l_ * W_LAYER; \
                if (r_ < I_IN) { const int kb = r_ / 160, nb = r_ % 160; W_ = w_in + (size_t)l_ * DM * NIN; ldw_ = NIN; gk_ = norm1 + l_ * DM; WT_ = (bf16*)(wl_ + W_IN); ldt_ = DM; dr_ = 32 * nb; sc_ = win_src_col(32 * nb); k0_ = 64 * kb; } \
                else if ((r_ -= I_IN) < I_A) { const int kb = r_ / 32, nb = r_ % 32; W_ = w_a + (size_t)l_ * 512 * DM; ldw_ = DM; gk_ = nullptr; WT_ = (bf16*)(wl_ + W_A); ldt_ = 512; dr_ = 32 * nb; sc_ = 32 * nb; k0_ = 64 * kb; } \
                else if ((r_ -= I_A) < I_A) { const int kb = r_ / 32, nb = r_ % 32; W_ = w_b + (size_t)l_ * 512 * DM; ldw_ = DM; gk_ = nullptr; WT_ = (bf16*)(wl_ + W_B); ldt_ = 512; dr_ = 32 * nb; sc_ = 32 * nb; k0_ = 64 * kb; } \
                else if ((r_ -= I_A) < I_O) { const int kb = r_ / 32, nb = r_ % 32; W_ = w_out + (size_t)l_ * DM * DM; ldw_ = DM; gk_ = nullptr; WT_ = (bf16*)(wl_ + W_OUT); ldt_ = DM; dr_ = 32 * nb; sc_ = 32 * nb; k0_ = 64 * kb; } \
                else if ((r_ -= I_O) < I_UP) { const int kb = r_ / 128, nb = r_ % 128; W_ = w_up + (size_t)l_ * DM * DFF; ldw_ = DFF; gk_ = norm2 + l_ * DM; WT_ = (bf16*)(wl_ + W_UP); ldt_ = DM; dr_ = 32 * nb; sc_ = 32 * nb; k0_ = 64 * kb; } \
                else { r_ -= I_UP; const int kb = r_ / 32, nb = r_ % 32; W_ = w_dn + (size_t)l_ * DFF * DM; ldw_ = DM; gk_ = nullptr; WT_ = (bf16*)(wl_ + W_DN); ldt_ = DFF; dr_ = 32 * nb; sc_ = 32 * nb; k0_ = 64 * kb; } } while (0)
            for (int it = gw; it < 2 * NIT; it += 2 * NGW) {
                const bool hb = it + NGW < 2 * NIT; const int itb = hb ? it + NGW : it;
                const float* Wa; const float* ga; bf16* Ta; int lwa, lta, dra, sca, k0a; TI_DEC(it, Wa, lwa, ga, Ta, lta, dra, sca, k0a);
                const float* Wb; const float* gb; bf16* Tb; int lwb, ltb, drb, scb, k0b; TI_DEC(itb, Wb, lwb, gb, Tb, ltb, drb, scb, k0b);
                float va[32], vb[32];
                ti_load(Wa, lwa, sca, k0a, lane, va);
                ti_load(Wb, lwb, scb, k0b, lane, vb);
                ti_finish(va, ga, Ta, lta, dra, k0a, scr, lane);
                if (hb) ti_finish(vb, gb, Tb, ltb, drb, k0b, scr, lane);
            }
#undef TI_DEC
            for (int i = bx * 512 + tid; i < 2 * 8 * 1024; i += G * 512) { const int l = i >> 13, hh = (i >> 10) & 7, k = i & 1023; WF[i] = w_in[(size_t)l * DM * NIN + (size_t)k * NIN + 1536 + hh] * norm1[l * DM + k]; }
            for (int i = bx * 512 + tid; i < 4 * MTOK; i += G * 512) RS[MTOK + i] = 0.f;
            for (int m = gw; m < MTOK; m += 4 * NGW) {
                f32x4 vx[4][4]; float sx[4]; int mr[4];
#pragma unroll
                for (int r = 0; r < 4; ++r) { const int mm = m + r * NGW; mr[r] = mm < MTOK ? mm : m;
                    const f32x4* xp = (const f32x4*)(x_in + (size_t)mr[r] * DM) + lane;
#pragma unroll
                    for (int j = 0; j < 4; ++j) vx[r][j] = xp[64 * j]; }
#pragma unroll
                for (int r = 0; r < 4; ++r) { float s = 0.f;
#pragma unroll
                    for (int j = 0; j < 4; ++j) s += (vx[r][j].x * vx[r][j].x + vx[r][j].y * vx[r][j].y) + (vx[r][j].z * vx[r][j].z + vx[r][j].w * vx[r][j].w);
                    sx[r] = wave_sum(s); }
#pragma unroll
                for (int r = 0; r < 4; ++r) { if (m + r * NGW < MTOK) { u32x2* op = (u32x2*)(XB + (size_t)mr[r] * DM) + lane;
#pragma unroll
                        for (int j = 0; j < 4; ++j) { u32x2 w2; w2.x = pk2(vx[r][j].x, vx[r][j].y); w2.y = pk2(vx[r][j].z, vx[r][j].w); op[64 * j] = w2; }
                        if (lane == 0) RS[mr[r]] = sx[r]; } }
            }
        } else if ((PHMASK & 256) && ph == 15) { PH_BEGIN
            const float* rs = RS + 4 * MTOK;
            f32x4 gq[4];
#pragma unroll
            for (int j = 0; j < 4; ++j) gq[j] = ((const f32x4*)fnorm)[lane + 64 * j];
            for (int m = gw; m < MTOK; m += 2 * NGW) {
                const int m2 = m + NGW; const bool has2 = m2 < MTOK;
                f32x4* xa = (f32x4*)(X + (size_t)m * DM) + lane; f32x4* xc = (f32x4*)(X + (size_t)(has2 ? m2 : m) * DM) + lane;
                f32x4 va[4], vc[4];
#pragma unroll
                for (int j = 0; j < 4; ++j) { va[j] = xa[64 * j]; vc[j] = xc[64 * j]; }
                const float ra = rstd_of(rs[m]), rc = rstd_of(rs[has2 ? m2 : m]);
                asm volatile("" ::: "memory");
#pragma unroll
                for (int j = 0; j < 4; ++j) { f32x4 o; o.x = va[j].x * ra * gq[j].x; o.y = va[j].y * ra * gq[j].y; o.z = va[j].z * ra * gq[j].z; o.w = va[j].w * ra * gq[j].w; xa[64 * j] = o; }
                if (has2) {
#pragma unroll
                    for (int j = 0; j < 4; ++j) { f32x4 o; o.x = vc[j].x * rc * gq[j].x; o.y = vc[j].y * rc * gq[j].y; o.z = vc[j].z * rc * gq[j].z; o.w = vc[j].w * rc * gq[j].w; xc[64 * j] = o; } }
            }
        } else {
            const int l = (ph - 1) / 7, k = (ph - 1) % 7;
            unsigned char* wl = ws + WS_W + l * W_LAYER;
            const float* rs1 = RS + (size_t)(2 * l) * MTOK; float* rs2 = RS + (size_t)(2 * l + 1) * MTOK; float* rs3 = RS + (size_t)(2 * l + 2) * MTOK;
            if ((PHMASK & 2) && k == 0) { PH_BEGIN
                { pg8::Gemm g{XB, (const bf16*)(wl + W_IN), MTOK, 4096, DM, nullptr, nullptr}; pg8::StaticOrder S; S.init(MTOK, 4096, G, bx); EpiProj E{PB, rs1};
                  pg8::gemm_phase<EpiProj, pg8::StaticOrder, true, true>(lds, g, S, E); }
                { pg8::Gemm g{(const bf16*)(wl + W_IN) + (size_t)4096 * DM, XB, 1024, MTOK, DM, nullptr, nullptr}; pg8::StaticOrder S; S.init(1024, MTOK, G, bx); EpiVt E{VT, rs1};
                  pg8::gemm_phase<EpiVt, pg8::StaticOrder, true, true>(lds, g, S, E); }
                f32x4 wq[8][4];
#pragma unroll
                for (int hh = 0; hh < 8; ++hh) { const f32x4* wp = (const f32x4*)(WF + l * 8192 + hh * 1024 + 8 * lane); wq[hh][0] = wp[0]; wq[hh][1] = wp[1]; wq[hh][2] = wp[128]; wq[hh][3] = wp[129]; }
                u32x4 nx[2][2] = {};
#pragma unroll
                for (int rr = 0; rr < 2; ++rr) { const int mr = gw + rr * NGW; if (mr < MTOK) { nx[rr][0] = *(const u32x4*)(XB + (size_t)mr * DM + 8 * lane); nx[rr][1] = *(const u32x4*)(XB + (size_t)mr * DM + 512 + 8 * lane); } }
                for (int m0 = gw; m0 < MTOK; m0 += 2 * NGW) {
                  u32x4 cu[2][2];
#pragma unroll
                  for (int rr = 0; rr < 2; ++rr) { cu[rr][0] = nx[rr][0]; cu[rr][1] = nx[rr][1]; }
#pragma unroll
                  for (int rr = 0; rr < 2; ++rr) { const int mr = m0 + (2 + rr) * NGW; if (mr < MTOK) { nx[rr][0] = *(const u32x4*)(XB + (size_t)mr * DM + 8 * lane); nx[rr][1] = *(const u32x4*)(XB + (size_t)mr * DM + 512 + 8 * lane); } }
#pragma unroll
                  for (int rr = 0; rr < 2; ++rr) { const int m = m0 + rr * NGW; if (m < MTOK) {
                    const u32x4 xa = cu[rr][0], xc = cu[rr][1];
                    float xv[16] = {bf_lo(xa.x), bf_hi(xa.x), bf_lo(xa.y), bf_hi(xa.y), bf_lo(xa.z), bf_hi(xa.z), bf_lo(xa.w), bf_hi(xa.w),
                                    bf_lo(xc.x), bf_hi(xc.x), bf_lo(xc.y), bf_hi(xc.y), bf_lo(xc.z), bf_hi(xc.z), bf_lo(xc.w), bf_hi(xc.w)};
                    const float r = rstd_of(rs1[m]); float dd[8];
#pragma unroll
                    for (int hh = 0; hh < 8; ++hh) { const f32x4 w0 = wq[hh][0], w1 = wq[hh][1], w2 = wq[hh][2], w3 = wq[hh][3];
                        dd[hh] = xv[0] * w0.x + xv[1] * w0.y + xv[2] * w0.z + xv[3] * w0.w + xv[4] * w1.x + xv[5] * w1.y + xv[6] * w1.z + xv[7] * w1.w
                               + xv[8] * w2.x + xv[9] * w2.y + xv[10] * w2.z + xv[11] * w2.w + xv[12] * w3.x + xv[13] * w3.y + xv[14] * w3.z + xv[15] * w3.w; }
                    float e4[4], e2[2], mine;
                    { const bool up = (lane & 32) != 0;
#pragma unroll
                      for (int j = 0; j < 4; ++j) { const float keep = up ? dd[4 + j] : dd[j], send = up ? dd[j] : dd[4 + j]; e4[j] = keep + __shfl_xor(send, 32); } }
                    { const bool up = (lane & 16) != 0;
#pragma unroll
                      for (int j = 0; j < 2; ++j) { const float keep = up ? e4[2 + j] : e4[j], send = up ? e4[j] : e4[2 + j]; e2[j] = keep + __shfl_xor(send, 16); } }
                    { const bool up = (lane & 8) != 0; const float keep = up ? e2[1] : e2[0], send = up ? e2[0] : e2[1]; mine = keep + __shfl_xor(send, 8); }
                    mine += __shfl_xor(mine, 4); mine += __shfl_xor(mine, 2); mine += __shfl_xor(mine, 1);
                    if ((lane & 7) == 0) { const int hh = lane >> 3; const float z = mine * r + fbias[l * 8 + hh]; const float az = fabsf(z);
                        const float ls = fminf(z, 0.f) - log1pf(__expf(-az));
                        const int b = m >> 13, s = m & 8191; LOGF[(size_t)(b * 8 + hh) * SEQ + s] = ls * LOG2E; }
                  } }
                }
            } else if ((PHMASK & 4) && k == 1) { PH_BEGIN
                int sq0 = bx, sq1 = 32, sqs = G;
                if (G == 256) { if ((bx & 31) < 2) { const int j_ = (bx >> 5) * 2 + (bx & 1); sq0 = 2 * j_; sq1 = 2 * j_ + 2; } else { sq0 = 0; sq1 = 0; } sqs = 1; }
                for (int sq = sq0; sq < sq1; sq += sqs) {
                    const f32x4* src = (const f32x4*)(LOGF + (size_t)sq * SEQ) + tid * 4; f32x4 v[4]; float run = 0.f;
#pragma unroll
                    for (int j = 0; j < 4; ++j) { v[j] = src[j]; v[j].x += run; v[j].y += v[j].x; v[j].z += v[j].y; v[j].w += v[j].z; run = v[j].w; }
                    float inc = run;
#pragma unroll
                    for (int o = 1; o < 64; o <<= 1) { const float t = __shfl_up(inc, o); if (lane >= o) inc += t; }
                    LAS float* wt = (LAS float*)lds;
                    if (lane == 63) wt[wave] = inc;
                    __syncthreads();
                    float off = inc - run;
                    for (int ww = 0; ww < wave; ++ww) off += wt[ww];
                    f32x4* dst = (f32x4*)(C2B + (size_t)sq * SEQ) + tid * 4;
#pragma unroll
                    for (int j = 0; j < 4; ++j) { v[j].x += off; v[j].y += off; v[j].z += off; v[j].w += off; dst[j] = v[j]; }
                    __syncthreads();
                }
                for (int ti = bx; ti < 256; ti += G) {
                    const int bh = ti >> 3, part = ti & 7; float mxv = 0.f;
#pragma unroll
                    for (int rr = 0; rr < 16; ++rr) { const int srw = part * 1024 + rr * 64 + (tid >> 3);
                        const u32x4 kv = *(const u32x4*)(PB + ((size_t)(bh >> 3) * SEQ + srw) * PW + 512 + (bh & 7) * 64 + (tid & 7) * 8);
                        float s2 = bf_lo(kv.x) * bf_lo(kv.x) + bf_hi(kv.x) * bf_hi(kv.x) + bf_lo(kv.y) * bf_lo(kv.y) + bf_hi(kv.y) * bf_hi(kv.y)
                                 + bf_lo(kv.z) * bf_lo(kv.z) + bf_hi(kv.z) * bf_hi(kv.z) + bf_lo(kv.w) * bf_lo(kv.w) + bf_hi(kv.w) * bf_hi(kv.w);
                        s2 += __shfl_xor(s2, 1); s2 += __shfl_xor(s2, 2); s2 += __shfl_xor(s2, 4);
                        mxv = fmaxf(mxv, s2); }
#pragma unroll
                    for (int o = 8; o < 64; o <<= 1) mxv = fmaxf(mxv, __shfl_xor(mxv, o));
                    if (lane == 0) atomicMax((unsigned*)(ws + WS_MISC) + l * 32 + bh, __builtin_bit_cast(unsigned, sqrtf(mxv))); }
                for (int ui = bx; ui < 1024; ui += G) { const int bh = ui >> 5, qb = ui & 31;
                    attn_unit<false>(lds, bh >> 3, bh & 7, qb, PB, VT, C2B, relb + (size_t)(l * 8 + (bh & 7)) * NREL, OB, 0.f); }
            } else if ((PHMASK & 8) && k == 2) {
                { int tid_q = threadIdx.x; asm volatile("" : "+v"(tid_q));
                  LAS unsigned* qslot = (LAS unsigned*)(lds + 131072 + 64);
                  unsigned* qhead = (unsigned*)(ws + WS_MISC) + 64 + pc;   const unsigned* knp = (const unsigned*)(ws + WS_MISC) + l * 32;
                  for (;;) {
                      if (tid_q == 0) *qslot = atomicAdd(qhead, 1u);
                      __syncthreads();
                      const int ui = (int)__builtin_amdgcn_readfirstlane(*qslot);
                      __syncthreads();
                      if (ui >= 1024) break;
                      const int bh = ui & 31, qb = 31 - (ui >> 5);
                      attn_unit<true>(lds, bh >> 3, bh & 7, qb, PB, VT, C2B, relb, OA, __builtin_bit_cast(float, knp[bh])); } }
            } else if ((PHMASK & 16) && k == 3) {
                { pg8::Gemm g{OA, (const bf16*)(wl + W_A), MTOK, DM, 512, OB, (const bf16*)(wl + W_B)}; DualOrder S; S.init(MTOK, DM, G, bx); EpiMergeDual E{MG, PB};
                  pg8::gemm_phase<EpiMergeDual, DualOrder, true, true>(lds, g, S, E); }
            } else if ((PHMASK & 32) && k == 4) {
                pg8::Gemm g{MG, (const bf16*)(wl + W_OUT), MTOK, DM, DM, nullptr, nullptr}; pg8::StaticOrder S; S.init(MTOK, DM, G, bx); EpiResid E{l == 0 ? x_in : X, X, XB, rs2, nullptr};
                pg8::gemm_phase<EpiResid, pg8::StaticOrder, true, true>(lds, g, S, E);
            } else if ((PHMASK & 64) && k == 5) {
#ifdef PROBE_KLOOP
                pg8::Gemm g{XB, (const bf16*)(wl + W_UP), MTOK, DFF, DM, XB, (const bf16*)(wl + W_UP)}; DualOrder S; S.init(MTOK, DFF, G, bx); EpiUpProbe E{UB};
                pg8::gemm_phase<EpiUpProbe, DualOrder, true, true>(lds, g, S, E);
#else
                pg8::Gemm g{XB, (const bf16*)(wl + W_UP), MTOK, DFF, DM, nullptr, nullptr}; pg8::StaticOrder S; S.init(MTOK, DFF, G, bx); EpiUp E{UB, rs2};
                pg8::gemm_phase<EpiUp, pg8::StaticOrder, true, true>(lds, g, S, E);
#endif
            } else if (PHMASK & 128) {
                pg8::Gemm g{UB, (const bf16*)(wl + W_DN), MTOK, DM, DFF, nullptr, nullptr}; pg8::StaticOrder S; S.init(MTOK, DM, G, bx);
                if (l == 1 && G == 256) { EpiResidNorm E{X, X, rs3, rs2, fnorm, (unsigned*)(ws + WS_MISC) + 128};
                    pg8::gemm_phase<EpiResidNorm, pg8::StaticOrder, true, true>(lds, g, S, E); }
                else { EpiResid E{X, X, XB, rs3, rs2};
                    pg8::gemm_phase<EpiResid, pg8::StaticOrder, true, true>(lds, g, S, E); }
            }
        }
        if (pc + 1 < p.ph_hi) {
            XcdBarrier xb_; xb_.bar = (unsigned*)(pp->ws + WS_BAR); xb_.x = xb_xcc_id(); xb_.st = bar_st; xcd_barrier(xb_);
        }
    }
}

constexpr int LDS_BYTES = 135168;

extern "C" void kernel_launch(void* const* d_in, const int* in_sizes, int n_in, void* d_out, int out_size, void* d_ws, size_t ws_size, hipStream_t stream) {
    static int grid_blocks = 0;
    if (grid_blocks == 0) {
        if (n_in != 12 || out_size != MTOK * DM || ws_size < WS_END) { fprintf(stderr, "kernel_launch: unexpected shapes (n_in %d out %d ws %zu)\n", n_in, out_size, ws_size); grid_blocks = -1; return; }
        int dev = 0, cus = 0, per_cu = 0;
        hipGetDevice(&dev);
        hipDeviceGetAttribute(&cus, hipDeviceAttributeMultiprocessorCount, dev);
        if (hipFuncSetAttribute((const void*)mega_fwd, hipFuncAttributeMaxDynamicSharedMemorySize, LDS_BYTES) != hipSuccess) { fprintf(stderr, "kernel_launch: hipFuncSetAttribute failed\n"); grid_blocks = -1; return; }
        if (hipOccupancyMaxActiveBlocksPerMultiprocessor(&per_cu, (const void*)mega_fwd, 512, LDS_BYTES) != hipSuccess || per_cu < 1) { fprintf(stderr, "kernel_launch: occupancy query gave %d\n", per_cu); per_cu = 1; (void)hipGetLastError(); }
        grid_blocks = cus * per_cu;
    }
    if (grid_blocks < 0) return;
    Params p{};
    for (int i = 0; i < 12; ++i) p.in[i] = (const float*)d_in[i];
    p.out = (float*)d_out; p.ws = (unsigned char*)d_ws; p.ph_lo = 0;
#ifdef PROBE_K
    p.ph_hi = 18;
#else
    p.ph_hi = (grid_blocks == 256) ? 15 : 16;
#endif
    if (hipMemsetAsync((char*)d_ws + WS_BAR, 0, WS_MISC + 1024 - WS_BAR, stream) != hipSuccess) { fprintf(stderr, "kernel_launch: hipMemsetAsync failed\n"); return; }
    void* args[] = {&p};
    hipError_t e = hipLaunchCooperativeKernel((const void*)mega_fwd, dim3(grid_blocks), dim3(512), args, LDS_BYTES, stream);
    if (e != hipSuccess) fprintf(stderr, "cooperative launch failed: %s (grid %d)\n", hipGetErrorString(e), grid_blocks);
}
```
